# Optimizing an MI355X kernel written in HIP

```python
import jax, jax.numpy as jnp
from jax import lax
import numpy as np

D_MODEL = 1024
BATCH = 16
SEQ = 4096
DEPTH = 1
DEC_BATCH = 32
DEC_SEQ = 64
PAST_LEN = 2048

CHUNK = 64
D_HG = 512
HG_HEADS = 4
HG_DK = 128
HG_DV = 128
D_SW = 512
SW_HEADS = 8
SW_KV = 2
SW_GROUP = SW_HEADS // SW_KV
SW_HD = 64
WINDOW = 128
N_WIN = WINDOW // CHUNK
D_FF = 2816
D_IN = 4 * D_HG + (SW_HEADS + 2 * SW_KV) * SW_HD
N_MOD = 9
EPS = 1e-6

kernel_name = 'hymba_hgrn2_swa_sink_macaron_adaln_stream'


def rmsnorm(x, g):
    xf = x.astype(jnp.float32)
    y = xf * lax.rsqrt(jnp.mean(xf * xf, axis=-1, keepdims=True) + EPS)
    return (y * g.astype(jnp.float32)).astype(x.dtype)


def adaln(c, w, b):
    m = jax.nn.silu(c) @ w + b
    return jnp.split(m[:, None, :], N_MOD, axis=-1)


def modulate(x, g, shift, scale):
    return rmsnorm(x, g) * (1.0 + scale) + shift


def swiglu(h, w_up, w_down):
    gate, up = jnp.split(h @ w_up, 2, axis=-1)
    return (jax.nn.silu(gate) * up) @ w_down


def hgrn_lower_bound(lb_logits, layer):
    p = jax.nn.softmax(lb_logits.astype(jnp.float32), axis=0)
    return jnp.cumsum(p, axis=0)[layer]


def alibi_slopes():
    return jnp.exp2(-8.0 * jnp.arange(1, SW_HEADS + 1, dtype=jnp.float32) / SW_HEADS)


def in_projection(h, w_in, lb):
    lead = h.shape[:-1]
    o1 = 4 * D_HG
    o2 = o1 + SW_HEADS * SW_HD
    o3 = o2 + SW_KV * SW_HD
    q, f, i, og, sq, sk, sv = jnp.split(h @ w_in, [D_HG, 2 * D_HG, 3 * D_HG, o1, o2, o3], axis=-1)
    forget = lb + (1.0 - lb) * jax.nn.sigmoid(f.astype(jnp.float32))
    heads = lambda t, d: t.reshape(*lead, -1, d)
    hq = heads(jax.nn.silu(q.astype(jnp.float32)), HG_DK)
    hk = heads(1.0 - forget, HG_DK)
    hg = heads(jnp.log(forget), HG_DK)
    hv = heads(i.astype(jnp.float32), HG_DV)
    return hq, hk, hv, hg, heads(og, HG_DV), heads(sq, SW_HD), heads(sk, SW_HD), heads(sv, SW_HD)


def hgrn_chunk(S, q, k, v, g):
    L = q.shape[2]
    b = jnp.cumsum(g, axis=2)
    inter = jnp.einsum('bhtk,bhkv->bhtv', q * jnp.exp(b), S)
    causal = jnp.tril(jnp.ones((L, L), dtype=bool))
    diff = b[:, :, :, None, :] - b[:, :, None, :, :]
    decay = jnp.exp(jnp.where(causal[:, :, None], diff, -jnp.inf))
    A = jnp.einsum('bhtk,bhsk,bhtsk->bhts', q, k, decay)
    o = inter + jnp.einsum('bhts,bhsv->bhtv', A, v)
    b_last = b[:, :, -1:, :]
    S_new = jnp.exp(b_last[:, :, 0, :])[..., None] * S + jnp.einsum('bhsk,bhsv->bhkv', k * jnp.exp(b_last - b), v)
    return S_new, o


def hgrn_prompt(q, k, v, g):
    B, S_len = q.shape[:2]
    nc = S_len // CHUNK
    blocks = lambda t: t.reshape(B, nc, CHUNK, HG_HEADS, t.shape[-1]).transpose(1, 0, 3, 2, 4)
    S0 = jnp.zeros((B, HG_HEADS, HG_DK, HG_DV), jnp.float32)
    S_fin, o = lax.scan(lambda S, inp: hgrn_chunk(S, *inp), S0, (blocks(q), blocks(k), blocks(v), blocks(g)))
    o = o.transpose(1, 0, 3, 2, 4).reshape(B, S_len, HG_HEADS, HG_DV)
    return o, S_fin


def hgrn_readout(o, og, g_norm):
    y = rmsnorm(o, g_norm) * jax.nn.silu(og.astype(jnp.float32))
    return y.reshape(*o.shape[:-2], D_HG)


def sink_attention(q, k, v, q_pos, k_pos, k_valid, sinks):
    B, N, Lq = q.shape[:3]
    qg = q.reshape(B, N, Lq, SW_KV, SW_GROUP, SW_HD)
    s = jnp.einsum('bnqhgd,bnshd->bnhgqs', qg, k).astype(jnp.float32) * (SW_HD ** -0.5)
    slopes = alibi_slopes().reshape(SW_KV, SW_GROUP)
    dist = jnp.abs(q_pos[:, :, None] - k_pos[:, None, :]).astype(jnp.float32)
    s = s - slopes[None, None, :, :, None, None] * dist[None, :, None, None, :, :]
    s = jnp.where(k_valid[None, :, None, None, None, :], s, -jnp.inf)
    sink = sinks.astype(jnp.float32).reshape(SW_KV, SW_GROUP)[None, None, :, :, None, None]
    m = jnp.maximum(jnp.max(s, axis=-1, keepdims=True), sink)
    p = jnp.exp(s - m)
    p = p / (jnp.sum(p, axis=-1, keepdims=True) + jnp.exp(sink - m))
    o = jnp.einsum('bnhgqs,bnshd->bnqhgd', p.astype(v.dtype), v)
    return o.reshape(B, N, Lq, SW_HEADS * SW_HD)


def band_blocks(t):
    B, S_len = t.shape[:2]
    nc = S_len // CHUNK
    tp = jnp.pad(t, ((0, 0), (WINDOW, 0), (0, 0), (0, 0))).reshape(B, nc + N_WIN, CHUNK, SW_KV, SW_HD)
    return jnp.concatenate([tp[:, j:j + nc] for j in range(N_WIN + 1)], axis=2)


def mixer_prompt(h, w_in, lb, g_hgrn, sinks, w_out):
    B, S_len, _ = h.shape
    nc = S_len // CHUNK
    hq, hk, hv, hg, og, sq, sk, sv = in_projection(h, w_in, lb)
    o_hg, S_fin = hgrn_prompt(hq, hk, hv, hg)
    y_hg = hgrn_readout(o_hg, og, g_hgrn)
    q_pos = jnp.arange(nc)[:, None] * CHUNK + jnp.arange(CHUNK)[None, :]
    k_pos = jnp.arange(nc)[:, None] * CHUNK - WINDOW + jnp.arange((N_WIN + 1) * CHUNK)[None, :]
    y_sw = sink_attention(sq.reshape(B, nc, CHUNK, SW_HEADS, SW_HD), band_blocks(sk), band_blocks(sv),
                          q_pos, k_pos, k_pos >= 0, sinks).reshape(B, S_len, D_SW)
    out = jnp.concatenate([y_hg.astype(h.dtype), y_sw.astype(h.dtype)], axis=-1) @ w_out
    return out, S_fin, sk[:, -WINDOW:], sv[:, -WINDOW:]


def mixer_sample(h, S0, k_cache, v_cache, w_in, lb, g_hgrn, sinks, w_out):
    B, L, _ = h.shape
    hq, hk, hv, hg, og, sq, sk, sv = in_projection(h, w_in, lb)
    tr = lambda t: t.transpose(0, 2, 1, 3)
    S_new, o = hgrn_chunk(S0.astype(jnp.float32), tr(hq), tr(hk), tr(hv), tr(hg))
    y_hg = hgrn_readout(tr(o), og, g_hgrn)
    n_cache = k_cache.shape[1]
    k_all = jnp.concatenate([k_cache.astype(sk.dtype), sk], axis=1)
    v_all = jnp.concatenate([v_cache.astype(sv.dtype), sv], axis=1)
    q_pos = (n_cache + jnp.arange(L))[None, :]
    k_pos = jnp.arange(n_cache + L)[None, :]
    y_sw = sink_attention(sq.reshape(B, 1, L, SW_HEADS, SW_HD), k_all[:, None], v_all[:, None],
                          q_pos, k_pos, k_pos >= 0, sinks).reshape(B, L, D_SW)
    out = jnp.concatenate([y_hg.astype(h.dtype), y_sw.astype(h.dtype)], axis=-1) @ w_out
    return out, S_new, k_all[:, -WINDOW:], v_all[:, -WINDOW:]


def block(x, c, mix, w_ada, b_ada, g_ffn1, w_up1, w_down1, g_mix, g_ffn2, w_up2, w_down2):
    sh1, sc1, gt1, sh2, sc2, gt2, sh3, sc3, gt3 = adaln(c, w_ada, b_ada)
    x = x + 0.5 * gt1 * swiglu(modulate(x, g_ffn1, sh1, sc1), w_up1, w_down1)
    m, S_new, k_new, v_new = mix(modulate(x, g_mix, sh2, sc2))
    x = x + gt2 * m
    x = x + 0.5 * gt3 * swiglu(modulate(x, g_ffn2, sh3, sc3), w_up2, w_down2)
    return x, S_new, k_new, v_new


def setup_inputs(seed: int = 0) -> dict:
    key = jax.random.key(seed)
    ks = jax.random.split(key, 24)
    nrm = lambda k, shape, s=1.0: jax.random.normal(k, shape, jnp.float32) * s
    n_win = min(WINDOW, PAST_LEN)
    return {
        'x_prompt': nrm(ks[0], (BATCH, SEQ, D_MODEL)),
        'x_sample': nrm(ks[1], (DEC_BATCH, DEC_SEQ, D_MODEL)),
        'state_hgrn': nrm(ks[2], (DEPTH, DEC_BATCH, HG_HEADS, HG_DK, HG_DV), 0.5),
        'cache_k': nrm(ks[3], (DEPTH, DEC_BATCH, n_win, SW_KV, SW_HD)),
        'cache_v': nrm(ks[4], (DEPTH, DEC_BATCH, n_win, SW_KV, SW_HD)),
        'c_prompt': nrm(ks[5], (BATCH, D_MODEL)),
        'c_sample': nrm(ks[6], (DEC_BATCH, D_MODEL)),
        'w_ada': nrm(ks[7], (DEPTH, D_MODEL, N_MOD * D_MODEL), D_MODEL ** -0.5),
        'b_ada': nrm(ks[8], (DEPTH, N_MOD * D_MODEL), 0.01),
        'g_ffn1': 1.0 + nrm(ks[9], (DEPTH, D_MODEL), 0.02),
        'w_up1': nrm(ks[10], (DEPTH, D_MODEL, 2 * D_FF), D_MODEL ** -0.5),
        'w_down1': nrm(ks[11], (DEPTH, D_FF, D_MODEL), D_FF ** -0.5),
        'g_mix': 1.0 + nrm(ks[12], (DEPTH, D_MODEL), 0.02),
        'w_in': nrm(ks[13], (DEPTH, D_MODEL, D_IN), D_MODEL ** -0.5),
        'lb_logits': nrm(ks[14], (DEPTH + 1, D_HG), 0.1),
        'g_hgrn': 1.0 + nrm(ks[15], (DEPTH, HG_DV), 0.02),
        'sinks': nrm(ks[16], (DEPTH, SW_HEADS), 0.5),
        'w_out': nrm(ks[17], (DEPTH, D_MODEL, D_MODEL), D_MODEL ** -0.5),
        'g_ffn2': 1.0 + nrm(ks[18], (DEPTH, D_MODEL), 0.02),
        'w_up2': nrm(ks[19], (DEPTH, D_MODEL, 2 * D_FF), D_MODEL ** -0.5),
        'w_down2': nrm(ks[20], (DEPTH, D_FF, D_MODEL), D_FF ** -0.5),
        'g_final': 1.0 + nrm(ks[21], (D_MODEL,), 0.02),
    }


def reference(x_prompt, x_sample, state_hgrn, cache_k, cache_v, c_prompt, c_sample,
              w_ada, b_ada, g_ffn1, w_up1, w_down1, g_mix, w_in, lb_logits, g_hgrn, sinks,
              w_out, g_ffn2, w_up2, w_down2, g_final):
    xp, xs = x_prompt, x_sample
    sp_list, kp_list, vp_list, ss_list, ks_list, vs_list = [], [], [], [], [], []
    for l in range(DEPTH):
        lb = hgrn_lower_bound(lb_logits, l)
        ffn = (w_ada[l], b_ada[l], g_ffn1[l], w_up1[l], w_down1[l], g_mix[l], g_ffn2[l], w_up2[l], w_down2[l])
        mix_p = lambda h: mixer_prompt(h, w_in[l], lb, g_hgrn[l], sinks[l], w_out[l])
        mix_s = lambda h: mixer_sample(h, state_hgrn[l], cache_k[l], cache_v[l], w_in[l], lb, g_hgrn[l], sinks[l], w_out[l])
        xp, sp, kp, vp = block(xp, c_prompt, mix_p, *ffn)
        xs, ss, kss, vss = block(xs, c_sample, mix_s, *ffn)
        sp_list.append(sp); kp_list.append(kp); vp_list.append(vp)
        ss_list.append(ss); ks_list.append(kss); vs_list.append(vss)
    y_prompt = rmsnorm(xp, g_final)
    y_sample = rmsnorm(xs, g_final)
    new_state_hgrn_prompt = jnp.stack(sp_list)
    new_cache_k_prompt = jnp.stack(kp_list)
    new_cache_v_prompt = jnp.stack(vp_list)
    new_state_hgrn_sample = jnp.stack(ss_list)
    new_cache_k_sample = jnp.stack(ks_list)
    new_cache_v_sample = jnp.stack(vs_list)
    return (y_prompt, y_sample, new_state_hgrn_prompt, new_cache_k_prompt, new_cache_v_prompt, new_state_hgrn_sample, new_cache_k_sample, new_cache_v_sample)
```

```cpp
#include <hip/hip_runtime.h>
#include <hip/hip_cooperative_groups.h>
#include <cstdio>
namespace cg = cooperative_groups;

#ifndef MK_LAUNCHES
#define MK_LAUNCHES 1
#endif

#define LAS __attribute__((address_space(3)))
typedef unsigned short bf16_t;
typedef short bf16x8 __attribute__((ext_vector_type(8)));
typedef float f32x4 __attribute__((ext_vector_type(4)));
typedef unsigned u32x4 __attribute__((ext_vector_type(4)));
typedef unsigned u32x2 __attribute__((ext_vector_type(2)));

constexpr int TP = 65536, TS = 2048, T = TP + TS, DM = 1024, DFF = 2816, DIN = 2816, NB = 48, NMOD = 9216;
constexpr int LDS_BYTES = 131072 + 8192;
constexpr int NPHASE = 12;

constexpr size_t O_Y = 0, O_STP = (size_t)T * DM, O_CKP = O_STP + 16 * 4 * 16384, O_CVP = O_CKP + 16 * 16384, O_STS = O_CVP + 16 * 16384,
                 O_CKS = O_STS + 32 * 4 * 16384, O_CVS = O_CKS + 32 * 16384;
constexpr size_t W_UP1 = 0, W_DN1 = W_UP1 + (size_t)2 * DFF * DM * 2, W_IN = W_DN1 + (size_t)DM * DFF * 2, W_OUT = W_IN + (size_t)DIN * DM * 2,
                 W_UP2 = W_OUT + (size_t)DM * DM * 2, W_DN2 = W_UP2 + (size_t)2 * DFF * DM * 2, W_MOD = W_DN2 + (size_t)DM * DFF * 2,
                 W_ZERO = W_MOD + (size_t)NB * NMOD * 4, W_H = W_ZERO + 65536, W_BIG = W_H + (size_t)T * DM * 2;
constexpr size_t Z_Q = 0, Z_K = Z_Q + (size_t)T * 512 * 2, Z_V = Z_K + (size_t)T * 512 * 2, Z_OG = Z_V + (size_t)T * 512 * 2, Z_SQ = Z_OG + (size_t)T * 512 * 2,
                 Z_G = Z_SQ + (size_t)T * 512 * 2, Z_SK = Z_G + (size_t)T * 512 * 4, Z_SV = Z_SK + (size_t)T * 128 * 2, Z_END = Z_SV + (size_t)T * 128 * 2;
constexpr size_t WS_NEED = W_BIG + Z_END;

struct Params {
    const float *x_p, *x_s, *state, *cache_k, *cache_v, *c_p, *c_s, *w_ada, *b_ada, *g_ffn1, *w_up1, *w_down1, *g_mix, *w_in, *lb_logits, *g_hgrn, *sinks, *w_out,
        *g_ffn2, *w_up2, *w_down2, *g_final;
    float* out;
    unsigned char* ws;
    int ph_lo, ph_hi;
};

typedef float f32x2 __attribute__((ext_vector_type(2)));
typedef __bf16 bf16x2_t __attribute__((ext_vector_type(2)));
__device__ __forceinline__ unsigned cvt_pk_bf16(float lo, float hi) { const f32x2 v = {lo, hi}; return __builtin_bit_cast(unsigned, __builtin_convertvector(v, bf16x2_t)); }
__device__ __forceinline__ float bf_lo(unsigned w) { return __uint_as_float(w << 16); }
__device__ __forceinline__ float bf_hi(unsigned w) { return __uint_as_float(w & 0xffff0000u); }
__device__ __forceinline__ float bf2f(bf16_t b) { return __uint_as_float(((unsigned)b) << 16); }
__device__ __forceinline__ float fsilu(float v) { return v * __builtin_amdgcn_rcpf(1.0f + __expf(-v)); }
__device__ __forceinline__ int batch_of_row(int row) { return row < TP ? (row >> 12) : 16 + ((row - TP) >> 6); }

namespace pg8 {
constexpr int BM = 256, BK = 64, HALF = 128, HTB = HALF * BK * 2, STAGE_BYTES = 8 * HTB, NXCD = 8, WGM = 8;
__device__ __forceinline__ int lds_byte(int r, int c) { const int st = (r >> 4) * 2 + (c >> 5), rr = r & 15, cc = c & 31, ob = rr * 64 + cc * 2; return st * 1024 + (ob ^ (((ob >> 9) & 1) << 5)); }
__device__ __forceinline__ void stage_rc(int b, int& R, int& C) { const int st = b / 1024, sb = b % 1024, swz = sb ^ (((sb >> 9) & 1) << 5); R = (st >> 1) * 16 + swz / 64; C = (st & 1) * 32 + (swz % 64) / 2; }
__device__ __forceinline__ int perm32(int rho) { const int n = rho >> 4, i = rho & 15; return 8 * (i >> 2) + 4 * n + (i & 3); }
struct Unit { int pm, pn; };
struct Gemm { const bf16_t* A; const bf16_t* Bt; int M, N, K; };
struct StaticOrder {
    int nM, nN, nwg, G, c;
    __device__ void init(int M, int N, int G_, int c_) { nM = M / BM; nN = N / BM; nwg = nM * nN; G = G_; c = c_; }
    __device__ bool next(int i, Unit& u) const {
        const long L = (long)i * G + c; if (L >= nwg) return false;
        int wgid = (int)L; { const int q = nwg / NXCD, r = nwg % NXCD, xcd = wgid % NXCD, off = wgid / NXCD; wgid = (xcd < r ? xcd * (q + 1) : r * (q + 1) + (xcd - r) * q) + off; }
        const int nig = WGM * nN, gid = wgid / nig, fm = gid * WGM, gsz = (nM - fm) < WGM ? (nM - fm) : WGM;
        u.pm = fm + ((wgid % nig) % gsz); u.pn = (wgid % nig) / gsz; return true;
    }
};

template <class Epi>
__device__ __forceinline__ void gemm_phase(LAS unsigned char* lds, const Gemm g, const StaticOrder& S, const Epi& E) {
    const int tid = threadIdx.x, wid = __builtin_amdgcn_readfirstlane(tid >> 6), lane = tid & 63, wr = wid >> 2, wc = wid & 3, fr = lane & 15, fq = lane >> 4;
    const int K = g.K, nt = K / BK;
    unsigned voffA[2], voffB[2];
#pragma unroll
    for (int i = 0; i < 2; ++i) { int R, C; stage_rc(tid * 16 + i * 8192, R, C); const int Rb = Epi::PERM ? ((R & ~31) + perm32(R & 31)) : R;
        voffA[i] = (unsigned)(R * K + C) * 2u; voffB[i] = (unsigned)(Rb * K + C) * 2u; }
    const size_t kstep = (size_t)(BK * 2);
    const size_t hstep = (size_t)HALF * K * 2;
    const size_t tstep = 2 * hstep;
    const unsigned ldsw = (unsigned)wid * 1024u;
    const int aoff = lds_byte(wr * 64 + fr, fq * 8), boff = lds_byte(wc * 32 + fr, fq * 8);
#define PG8_SA(b, h) (((b) * 2 + (h)) * HTB)
#define PG8_SB(b, h) ((4 + (b) * 2 + (h)) * HTB)
#define PG8_STAGE(bufoff, gbase, voff) do { _Pragma("unroll") for (int _i = 0; _i < 2; ++_i) \
        __builtin_amdgcn_global_load_lds((const unsigned*)((const char*)(gbase) + (voff)[_i]), (LAS unsigned*)(lds + (bufoff) + ldsw + _i * 8192), 16, 0, 0); } while (0)
#define PG8_LDA(dst, b, h) do { _Pragma("unroll") for (int m = 0; m < 4; ++m) _Pragma("unroll") for (int k = 0; k < 2; ++k) dst[m][k] = *(const LAS bf16x8*)(lds + PG8_SA(b, h) + aoff + m * 2048 + k * 1024); } while (0)
#define PG8_LDB(dst, b, h) do { _Pragma("unroll") for (int n = 0; n < 2; ++n) _Pragma("unroll") for (int k = 0; k < 2; ++k) dst[n][k] = *(const LAS bf16x8*)(lds + PG8_SB(b, h) + boff + n * 2048 + k * 1024); } while (0)
#define PG8_MMA(ai, bj, At, Bt) do { __builtin_amdgcn_s_setprio(1); _Pragma("unroll") for (int m = 0; m < 4; ++m) _Pragma("unroll") for (int n = 0; n < 2; ++n) _Pragma("unroll") for (int k = 0; k < 2; ++k) \
        acc[ai][bj][m][n] = __builtin_amdgcn_mfma_f32_16x16x32_bf16(Bt[n][k], At[m][k], acc[ai][bj][m][n], 0, 0, 0); __builtin_amdgcn_s_setprio(0); } while (0)
#define PG8_WAIT_V(n) asm volatile("s_waitcnt vmcnt(" #n ")" ::: "memory")
#define PG8_WAIT_L(n) asm volatile("s_waitcnt lgkmcnt(" #n ")" ::: "memory")
#define PG8_BAR __builtin_amdgcn_s_barrier()
#define PG8_SCHED __builtin_amdgcn_sched_barrier(0)
    Unit cur, nxt; int ui = 0;
    if (!S.next(0, cur)) return;
    f32x4 acc[2][2][4][2];
#pragma unroll
    for (int a = 0; a < 2; ++a)
#pragma unroll
        for (int b = 0; b < 2; ++b)
#pragma unroll
            for (int m = 0; m < 4; ++m)
#pragma unroll
                for (int n = 0; n < 2; ++n) acc[a][b][m][n] = (f32x4){0.f, 0.f, 0.f, 0.f};
    bf16x8 At[4][2], B0[2][2], B1[2][2];
    const char* cA = (const char*)g.A + (size_t)cur.pm * tstep; const char* cB = (const char*)g.Bt + (size_t)cur.pn * tstep;
    PG8_STAGE(PG8_SB(0, 0), cB, voffB); PG8_STAGE(PG8_SA(0, 0), cA, voffA); PG8_STAGE(PG8_SB(0, 1), cB + hstep, voffB); PG8_STAGE(PG8_SA(0, 1), cA + hstep, voffA);
    if (wr == 1) PG8_BAR;
    PG8_WAIT_V(4); PG8_BAR;
    PG8_STAGE(PG8_SB(1, 0), cB + kstep, voffB); PG8_STAGE(PG8_SA(1, 0), cA + kstep, voffA); PG8_STAGE(PG8_SB(1, 1), cB + hstep + kstep, voffB);
    PG8_WAIT_V(6); PG8_BAR;
    for (;;) {
        const bool has_next = S.next(ui + 1, nxt);
        const char* nA = has_next ? (const char*)g.A + (size_t)nxt.pm * tstep : cA; const char* nB = has_next ? (const char*)g.Bt + (size_t)nxt.pn * tstep : cB;
        for (int t = 0; t < nt; t += 2) {
            const bool last = (t == nt - 2);
            const char* a1 = cA + (size_t)(t + 1) * kstep;
            const char* a2 = last ? nA : cA + (size_t)(t + 2) * kstep; const char* b2 = last ? nB : cB + (size_t)(t + 2) * kstep;
            const char* a3 = a2 + kstep; const char* b3 = b2 + kstep;
            PG8_LDB(B0, 0, 0); PG8_SCHED; PG8_LDA(At, 0, 0); PG8_STAGE(PG8_SA(1, 1), a1 + hstep, voffA);
            PG8_WAIT_L(8); PG8_BAR; PG8_WAIT_L(0); PG8_MMA(0, 0, At, B0); PG8_BAR; PG8_SCHED;
            PG8_LDB(B1, 0, 1); PG8_STAGE(PG8_SB(0, 0), b2, voffB);
            PG8_BAR; PG8_WAIT_L(0); PG8_MMA(0, 1, At, B1); PG8_BAR;
            PG8_LDA(At, 0, 1); PG8_STAGE(PG8_SA(0, 0), a2, voffA);
            PG8_BAR; PG8_WAIT_L(0); PG8_MMA(1, 0, At, B0); PG8_BAR; PG8_SCHED;
            PG8_STAGE(PG8_SB(0, 1), b2 + hstep, voffB);
            PG8_WAIT_V(6); PG8_BAR; PG8_MMA(1, 1, At, B1); PG8_BAR;
            PG8_LDB(B0, 1, 0); PG8_SCHED; PG8_LDA(At, 1, 0); PG8_STAGE(PG8_SA(0, 1), a2 + hstep, voffA);
            PG8_WAIT_L(8); PG8_BAR; PG8_WAIT_L(0); PG8_MMA(0, 0, At, B0); PG8_BAR; PG8_SCHED;
            PG8_LDB(B1, 1, 1); PG8_STAGE(PG8_SB(1, 0), b3, voffB);
            PG8_BAR; PG8_WAIT_L(0); PG8_MMA(0, 1, At, B1); PG8_BAR;
            PG8_LDA(At, 1, 1); PG8_STAGE(PG8_SA(1, 0), a3, voffA);
            PG8_BAR; PG8_WAIT_L(0); PG8_MMA(1, 0, At, B0); PG8_BAR; PG8_SCHED;
            PG8_STAGE(PG8_SB(1, 1), b3 + hstep, voffB);
            PG8_WAIT_V(6); PG8_BAR; PG8_MMA(1, 1, At, B1); PG8_BAR;
        }
        E(acc, cur, wr, wc, fr, fq);
        if (!has_next) break;
#pragma unroll
        for (int a = 0; a < 2; ++a)
#pragma unroll
            for (int b = 0; b < 2; ++b)
#pragma unroll
                for (int m = 0; m < 4; ++m)
#pragma unroll
                    for (int n = 0; n < 2; ++n) acc[a][b][m][n] = (f32x4){0.f, 0.f, 0.f, 0.f};
        cur = nxt; cA = nA; cB = nB; ++ui;
    }
    PG8_WAIT_V(0);
    if (wr == 0) PG8_BAR;
    PG8_BAR;
#undef PG8_SA
#undef PG8_SB
#undef PG8_STAGE
#undef PG8_LDA
#undef PG8_LDB
#undef PG8_MMA
#undef PG8_WAIT_V
#undef PG8_WAIT_L
#undef PG8_BAR
#undef PG8_SCHED
}
}
using pg8::Unit;

struct EpiSwiglu {
    static constexpr bool PERM = true;
    bf16_t* H;
    __device__ __forceinline__ void operator()(const f32x4 (&acc)[2][2][4][2], const Unit& u, int wr, int wc, int fr, int fq) const {
        const int row0 = u.pm * 256 + wr * 64 + fr, col0 = u.pn * 128 + wc * 32 + 8 * fq;
#pragma unroll
        for (int ai = 0; ai < 2; ++ai)
#pragma unroll
            for (int m = 0; m < 4; ++m) {
                bf16_t* rowp = H + (size_t)(row0 + ai * 128 + m * 16) * DFF + col0;
                float v[8];
#pragma unroll
                for (int n = 0; n < 2; ++n)
#pragma unroll
                    for (int j = 0; j < 4; ++j) v[n * 4 + j] = fsilu(acc[ai][0][m][n][j]) * acc[ai][1][m][n][j];
                u32x4 w; w.x = cvt_pk_bf16(v[0], v[1]); w.y = cvt_pk_bf16(v[2], v[3]); w.z = cvt_pk_bf16(v[4], v[5]); w.w = cvt_pk_bf16(v[6], v[7]);
                *(u32x4*)rowp = w;
            }
    }
};
struct EpiResid {
    static constexpr bool PERM = false;
    const float* xa; const float* xb; float* out; const float* gate; float coef;
    __device__ __forceinline__ void operator()(const f32x4 (&acc)[2][2][4][2], const Unit& u, int wr, int wc, int fr, int fq) const {
        const int col0 = u.pn * 256 + wc * 32 + 4 * fq;
#pragma unroll
        for (int ai = 0; ai < 2; ++ai) {
            const int b = u.pm < 256 ? (u.pm >> 4) : 16 + (u.pm - 256) * 4 + ai * 2 + wr;
            const float* gp = gate + (size_t)b * NMOD + col0;
            f32x4 gv[2][2];
#pragma unroll
            for (int bj = 0; bj < 2; ++bj)
#pragma unroll
                for (int n = 0; n < 2; ++n) gv[bj][n] = *(const f32x4*)(gp + bj * 128 + n * 16) * coef;
#pragma unroll
            for (int m = 0; m < 4; ++m) {
                const int row = u.pm * 256 + ai * 128 + wr * 64 + m * 16 + fr;
                const float* bp = (row < TP ? xa + (size_t)row * DM : xb + (size_t)(row - TP) * DM) + col0;
                float* op = out + (size_t)row * DM + col0;
#pragma unroll
                for (int bj = 0; bj < 2; ++bj)
#pragma unroll
                    for (int n = 0; n < 2; ++n) { const f32x4 x = *(const f32x4*)(bp + bj * 128 + n * 16); *(f32x4*)(op + bj * 128 + n * 16) = x + gv[bj][n] * acc[ai][bj][m][n]; }
            }
        }
    }
};
struct EpiInproj {
    static constexpr bool PERM = true;
    unsigned char* big; const float* lbl; float* out;
    __device__ __forceinline__ void store8(bf16_t* p, const f32x4& a, const f32x4& b) const {
        u32x4 w; w.x = cvt_pk_bf16(a[0], a[1]); w.y = cvt_pk_bf16(a[2], a[3]); w.z = cvt_pk_bf16(b[0], b[1]); w.w = cvt_pk_bf16(b[2], b[3]); *(u32x4*)p = w;
    }
    __device__ __forceinline__ void operator()(const f32x4 (&acc)[2][2][4][2], const Unit& u, int wr, int wc, int fr, int fq) const {
        const int row0 = u.pm * 256 + wr * 64 + fr, cw = wc * 32 + 8 * fq;
        const int pn = u.pn;
        if (pn == 2 || pn == 3) {
            bf16_t* zk = (bf16_t*)(big + Z_K); float* zg = (float*)(big + Z_G);
#pragma unroll
            for (int bj = 0; bj < 2; ++bj) {
                const int cc = (pn - 2) * 256 + bj * 128 + cw;
                float lb[8];
#pragma unroll
                for (int j = 0; j < 8; ++j) lb[j] = 1.0f / (1.0f + expf(lbl[512 + cc + j] - lbl[cc + j]));
#pragma unroll
                for (int ai = 0; ai < 2; ++ai)
#pragma unroll
                    for (int m = 0; m < 4; ++m) {
                        const size_t row = (size_t)(row0 + ai * 128 + m * 16);
                        f32x4 kk[2], gg[2];
#pragma unroll
                        for (int n = 0; n < 2; ++n)
#pragma unroll
                            for (int j = 0; j < 4; ++j) {
                                const float f = acc[ai][bj][m][n][j], l = lb[n * 4 + j];
                                const float e = __expf(-f), sg = 1.0f / (1.0f + e);
                                const float forget = l + (1.0f - l) * sg;
                                kk[n][j] = (1.0f - l) * (1.0f - sg);
                                gg[n][j] = logf(forget);
                            }
                        store8(zk + row * 512 + cc, kk[0], kk[1]);
                        *(f32x4*)(zg + row * 512 + cc) = gg[0]; *(f32x4*)(zg + row * 512 + cc + 4) = gg[1];
                    }
            }
        } else if (pn == 10) {
#pragma unroll
            for (int bj = 0; bj < 2; ++bj) {
                bf16_t* z = (bf16_t*)(big + (bj ? Z_SV : Z_SK));
#pragma unroll
                for (int ai = 0; ai < 2; ++ai) {
                    float* cp = nullptr;
                    if (u.pm < 256) { if ((u.pm & 15) == 15 && ai == 1) cp = out + (bj ? O_CVP : O_CKP) + (size_t)(u.pm >> 4) * 16384 + (size_t)(wr * 64) * 128; }
                    else cp = out + (bj ? O_CVS : O_CKS) + (size_t)((u.pm - 256) * 4 + ai * 2 + wr) * 16384 + (size_t)64 * 128;
#pragma unroll
                    for (int m = 0; m < 4; ++m) {
                        const size_t row = (size_t)(row0 + ai * 128 + m * 16);
                        store8(z + row * 128 + cw, acc[ai][bj][m][0], acc[ai][bj][m][1]);
                        if (cp) { float* q = cp + (size_t)(m * 16 + fr) * 128 + cw; *(f32x4*)q = acc[ai][bj][m][0]; *(f32x4*)(q + 4) = acc[ai][bj][m][1]; }
                    }
                }
            }
        } else {
            const bool isq = pn < 2;
            const size_t zoff = pn < 2 ? Z_Q : (pn < 6 ? Z_V : (pn < 8 ? Z_OG : Z_SQ));
            const int cbase = (pn & 1) * 256;
            bf16_t* z = (bf16_t*)(big + zoff);
#pragma unroll
            for (int bj = 0; bj < 2; ++bj)
#pragma unroll
                for (int ai = 0; ai < 2; ++ai)
#pragma unroll
                    for (int m = 0; m < 4; ++m) {
                        const size_t row = (size_t)(row0 + ai * 128 + m * 16);
                        f32x4 a = acc[ai][bj][m][0], b = acc[ai][bj][m][1];
                        if (isq) {
#pragma unroll
                            for (int j = 0; j < 4; ++j) { a[j] = fsilu(a[j]); b[j] = fsilu(b[j]); }
                        }
                        store8(z + row * 512 + cbase + bj * 128 + cw, a, b);
                    }
        }
    }
};

__device__ __forceinline__ void cvt_tile(const float* src, bf16_t* dst, int K, int N, int mode, int tile, LAS float* tl) {
    const int tid = threadIdx.x;
    const int ntn = N >> 6, tk = tile / ntn, tn = tile - tk * ntn, k0 = tk * 64, n0 = tn * 64;
#pragma unroll
    for (int i = 0; i < 2; ++i) {
        const int r = (tid >> 4) + 32 * i, c4 = (tid & 15) * 4;
        const f32x4 v = *(const f32x4*)(src + (size_t)(k0 + r) * N + n0 + c4);
        tl[r * 65 + c4 + 0] = v[0]; tl[r * 65 + c4 + 1] = v[1]; tl[r * 65 + c4 + 2] = v[2]; tl[r * 65 + c4 + 3] = v[3];
    }
    __syncthreads();
    const int n = tid >> 3, kq = tid & 7;
    float v[8];
#pragma unroll
    for (int j = 0; j < 8; ++j) v[j] = tl[(kq * 8 + j) * 65 + n];
    int nd = n0 + n;
    if (mode == 1) { if (nd < DFF) nd = 256 * (nd >> 7) + (nd & 127); else { const int uu = nd - DFF; nd = 256 * (uu >> 7) + 128 + (uu & 127); } }
    u32x4 w; w.x = cvt_pk_bf16(v[0], v[1]); w.y = cvt_pk_bf16(v[2], v[3]); w.z = cvt_pk_bf16(v[4], v[5]); w.w = cvt_pk_bf16(v[6], v[7]);
    *(u32x4*)(dst + (size_t)nd * K + k0 + kq * 8) = w;
    __syncthreads();
}

__device__ __forceinline__ void adaln_strip(const Params& p, int strip, LAS unsigned char* lds) {
    LAS float* sc = (LAS float*)lds;
    const int tid = threadIdx.x, col = tid & 63, kg = tid >> 6;
    float acc[NB];
#pragma unroll
    for (int b = 0; b < NB; ++b) acc[b] = 0.f;
    for (int ch = 0; ch < 4; ++ch) {
        __syncthreads();
        for (int e = tid; e < NB * 256; e += 512) {
            const int b = e >> 8, kk = e & 255;
            const float c = b < 16 ? p.c_p[b * DM + ch * 256 + kk] : p.c_s[(b - 16) * DM + ch * 256 + kk];
            sc[kk * NB + b] = c / (1.0f + expf(-c));
        }
        __syncthreads();
        for (int kk = 0; kk < 32; ++kk) {
            const int kl = kg * 32 + kk, k = ch * 256 + kl;
            const float w = p.w_ada[(size_t)k * NMOD + strip * 64 + col];
            const LAS f32x4* s4 = (const LAS f32x4*)(sc + kl * NB);
#pragma unroll
            for (int b4 = 0; b4 < NB / 4; ++b4) { const f32x4 s = s4[b4]; acc[4 * b4] += s[0] * w; acc[4 * b4 + 1] += s[1] * w; acc[4 * b4 + 2] += s[2] * w; acc[4 * b4 + 3] += s[3] * w; }
        }
    }
    __syncthreads();
    LAS float* red = (LAS float*)lds;
#pragma unroll
    for (int b = 0; b < NB; ++b) red[(kg * NB + b) * 64 + col] = acc[b];
    __syncthreads();
    float* mod = (float*)(p.ws + W_MOD);
    for (int e = tid; e < NB * 64; e += 512) {
        const int b = e >> 6, c = e & 63;
        float s = 0.f;
#pragma unroll
        for (int g = 0; g < 8; ++g) s += red[(g * NB + b) * 64 + c];
        mod[(size_t)b * NMOD + strip * 64 + c] = s + p.b_ada[strip * 64 + c];
    }
    __syncthreads();
}

__device__ __forceinline__ void phase0(const Params& p, LAS unsigned char* lds) {
    if (blockIdx.x < 144) adaln_strip(p, blockIdx.x, lds);
    {
        const size_t n4 = (size_t)32 * 64 * 128 / 4;
        for (size_t i = (size_t)blockIdx.x * 512 + threadIdx.x; i < 2 * n4; i += (size_t)gridDim.x * 512) {
            const int which = i >= n4; const size_t j = which ? i - n4 : i;
            const size_t sb = j / 2048, r = j % 2048;
            const f32x4 v = *(const f32x4*)((which ? p.cache_v : p.cache_k) + sb * 16384 + 8192 + r * 4);
            *(f32x4*)(p.out + (which ? O_CVS : O_CKS) + sb * 16384 + r * 4) = v;
        }
    }
    for (int i = blockIdx.x * 512 + threadIdx.x; i < 16384; i += gridDim.x * 512) ((float*)(p.ws + W_ZERO))[i] = 0.f;
    LAS float* tl = (LAS float*)lds;
    for (int t = blockIdx.x; t < 5184; t += gridDim.x) {
        if (t < 1408) cvt_tile(p.w_up1, (bf16_t*)(p.ws + W_UP1), DM, 2 * DFF, 1, t, tl);
        else if (t < 2112) cvt_tile(p.w_down1, (bf16_t*)(p.ws + W_DN1), DFF, DM, 0, t - 1408, tl);
        else if (t < 2816) cvt_tile(p.w_in, (bf16_t*)(p.ws + W_IN), DM, DIN, 0, t - 2112, tl);
        else if (t < 3072) cvt_tile(p.w_out, (bf16_t*)(p.ws + W_OUT), DM, DM, 0, t - 2816, tl);
        else if (t < 4480) cvt_tile(p.w_up2, (bf16_t*)(p.ws + W_UP2), DM, 2 * DFF, 1, t - 3072, tl);
        else cvt_tile(p.w_down2, (bf16_t*)(p.ws + W_DN2), DFF, DM, 0, t - 4480, tl);
    }
}

__device__ __forceinline__ float wave_sum(float v) {
#pragma unroll
    for (int o = 32; o > 0; o >>= 1) v += __shfl_xor(v, o);
    return v;
}
__device__ __forceinline__ void norm_mod_phase(const float* xa, const float* xb, const float* gvec, const float* mod, int shift_idx, int scale_idx, bf16_t* h) {
    const int wid = threadIdx.x >> 6, lane = threadIdx.x & 63;
    for (int row = blockIdx.x * 8 + wid; row < T; row += gridDim.x * 8) {
        const float* src = row < TP ? xa + (size_t)row * DM : xb + (size_t)(row - TP) * DM;
        const float* mrow = mod + (size_t)batch_of_row(row) * NMOD;
        f32x4 v[4];
#pragma unroll
        for (int i = 0; i < 2; ++i) { v[2 * i] = *(const f32x4*)(src + i * 512 + lane * 8); v[2 * i + 1] = *(const f32x4*)(src + i * 512 + lane * 8 + 4); }
        float ss = 0.f;
#pragma unroll
        for (int i = 0; i < 4; ++i) ss += v[i][0] * v[i][0] + v[i][1] * v[i][1] + v[i][2] * v[i][2] + v[i][3] * v[i][3];
        ss = wave_sum(ss);
        const float rstd = rsqrtf(ss * (1.0f / DM) + 1e-6f);
#pragma unroll
        for (int i = 0; i < 2; ++i) {
            const int c0 = i * 512 + lane * 8;
            float y[8];
#pragma unroll
            for (int q = 0; q < 2; ++q) {
                const f32x4 g = *(const f32x4*)(gvec + c0 + 4 * q), sc = *(const f32x4*)(mrow + scale_idx * DM + c0 + 4 * q), sh = *(const f32x4*)(mrow + shift_idx * DM + c0 + 4 * q);
#pragma unroll
                for (int j = 0; j < 4; ++j) y[4 * q + j] = v[2 * i + q][j] * rstd * g[j] * (1.0f + sc[j]) + sh[j];
            }
            u32x4 w; w.x = cvt_pk_bf16(y[0], y[1]); w.y = cvt_pk_bf16(y[2], y[3]); w.z = cvt_pk_bf16(y[4], y[5]); w.w = cvt_pk_bf16(y[6], y[7]);
            *(u32x4*)(h + (size_t)row * DM + c0) = w;
        }
    }
}
__device__ __forceinline__ void final_norm_phase(float* x, const float* gvec) {
    const int wid = threadIdx.x >> 6, lane = threadIdx.x & 63;
    for (int row = blockIdx.x * 8 + wid; row < T; row += gridDim.x * 8) {
        float* src = x + (size_t)row * DM;
        f32x4 v[4];
#pragma unroll
        for (int i = 0; i < 4; ++i) v[i] = *(const f32x4*)(src + i * 256 + lane * 4);
        float ss = 0.f;
#pragma unroll
        for (int i = 0; i < 4; ++i) ss += v[i][0] * v[i][0] + v[i][1] * v[i][1] + v[i][2] * v[i][2] + v[i][3] * v[i][3];
        ss = wave_sum(ss);
        const float rstd = rsqrtf(ss * (1.0f / DM) + 1e-6f);
#pragma unroll
        for (int i = 0; i < 4; ++i) { const f32x4 g = *(const f32x4*)(gvec + i * 256 + lane * 4); *(f32x4*)(src + i * 256 + lane * 4) = v[i] * rstd * g; }
    }
}

constexpr int HG_QS = 0, HG_KS = 17408, HG_KT = 34816, HG_VT = 53248, HG_AS = 71680, HG_ST = 80896, HG_DEC = 115712, HG_TOT = 116224, HG_SSQ = 118272;
__device__ __forceinline__ f32x4 mfma16(bf16x8 a, bf16x8 b, f32x4 c) { return __builtin_amdgcn_mfma_f32_16x16x32_bf16(a, b, c, 0, 0, 0); }

__device__ __forceinline__ void hgrn_unit(const Params& p, int row0, int nc, int h, const float* S0, float* Sout, LAS unsigned char* lds) {
    const unsigned char* big = p.ws + W_BIG;
    const bf16_t* zq = (const bf16_t*)(big + Z_Q); const bf16_t* zk = (const bf16_t*)(big + Z_K); const bf16_t* zv = (const bf16_t*)(big + Z_V);
    const bf16_t* zog = (const bf16_t*)(big + Z_OG); const float* zg = (const float*)(big + Z_G);
    bf16_t* ymix = (bf16_t*)(p.ws + W_H);
    LAS bf16_t* Qs = (LAS bf16_t*)(lds + HG_QS); LAS bf16_t* Ks = (LAS bf16_t*)(lds + HG_KS); LAS bf16_t* Kt = (LAS bf16_t*)(lds + HG_KT);
    LAS bf16_t* Vt = (LAS bf16_t*)(lds + HG_VT); LAS bf16_t* As = (LAS bf16_t*)(lds + HG_AS); LAS bf16_t* St = (LAS bf16_t*)(lds + HG_ST);
    LAS float* dec = (LAS float*)(lds + HG_DEC); LAS float* tot = (LAS float*)(lds + HG_TOT); LAS float* ssq = (LAS float*)(lds + HG_SSQ);
    const int tid = threadIdx.x, wid = __builtin_amdgcn_readfirstlane(tid >> 6), lane = tid & 63, fr = lane & 15, fq = lane >> 4;
    const int sg = wid >> 1, kc0 = (wid & 1) << 6, kcol = kc0 + lane;
    const int ttile = wid & 3, half = wid >> 2;
    const int vs = lane, v8 = wid;
    const unsigned lo_e = (unsigned)lane, lo_v = (unsigned)lane * 512u;

    __syncthreads();
    f32x4 Sacc[8];
#pragma unroll
    for (int vt = 0; vt < 8; ++vt) {
        {
            const float* sp = S0 + (size_t)(16 * wid) * 128 + 16 * vt;
            const unsigned so = (unsigned)fq * 512u + fr;
            Sacc[vt] = (f32x4){sp[so], sp[so + 128], sp[so + 256], sp[so + 384]};
        }
        u32x2 w; w.x = cvt_pk_bf16(Sacc[vt][0], Sacc[vt][1]); w.y = cvt_pk_bf16(Sacc[vt][2], Sacc[vt][3]);
        *(LAS u32x2*)(St + (16 * vt + fr) * 136 + 16 * wid + 4 * fq) = w;
    }
    float gg[16]; bf16_t qq[16], kk[16]; u32x4 vv[2];
    {
        const size_t ub = ((size_t)row0 + 16 * sg) * 512 + h * 128 + kc0;
        const float* gp = zg + ub; const bf16_t* qp = zq + ub; const bf16_t* kp = zk + ub;
#pragma unroll
        for (int i = 0; i < 16; ++i) { gg[i] = gp[i * 512 + lo_e]; qq[i] = qp[i * 512 + lo_e]; kk[i] = kp[i * 512 + lo_e]; }
        const bf16_t* vp = zv + (size_t)row0 * 512 + h * 128 + v8 * 8;
#pragma unroll
        for (int i = 0; i < 2; ++i) vv[i] = *(const u32x4*)(vp + i * 64 + lo_v);
    }
    for (int c = 0; c < nc; ++c) {
        const size_t rowc = (size_t)row0 + (size_t)c * 64;
#pragma unroll
        for (int i = 1; i < 16; ++i) gg[i] += gg[i - 1];
        tot[sg * 128 + kcol] = gg[15];
        __syncthreads();
        {
            const float t0 = tot[kcol], t1 = tot[128 + kcol], t2 = tot[256 + kcol], t3 = tot[384 + kcol];
            const float off = (sg > 0 ? t0 : 0.f) + (sg > 1 ? t1 : 0.f) + (sg > 2 ? t2 : 0.f);
            const float blast = (t0 + t1) + (t2 + t3);
            const float edec = __expf(blast);
            if (sg == 0) dec[kcol] = edec;
            unsigned kt[8];
#pragma unroll
            for (int i = 0; i < 16; i += 2) {
                float kt2[2];
#pragma unroll
                for (int j = 0; j < 2; ++j) {
                    const float bb = off + gg[i + j];
                    const float eb = __expf(bb), einv = __expf(-bb);
                    const float qf = bf2f(qq[i + j]) * eb, kh = bf2f(kk[i + j]) * einv;
                    kt2[j] = kh * edec;
                    const int s = 16 * sg + i + j;
                    Qs[s * 136 + kcol] = (bf16_t)(cvt_pk_bf16(qf, 0.f) & 0xffffu);
                    Ks[s * 136 + kcol] = (bf16_t)(cvt_pk_bf16(kh, 0.f) & 0xffffu);
                }
                kt[i >> 1] = cvt_pk_bf16(kt2[0], kt2[1]);
            }
            *(LAS u32x4*)(Kt + kcol * 72 + 16 * sg) = (u32x4){kt[0], kt[1], kt[2], kt[3]};
            *(LAS u32x4*)(Kt + kcol * 72 + 16 * sg + 8) = (u32x4){kt[4], kt[5], kt[6], kt[7]};
#pragma unroll
            for (int i = 0; i < 2; ++i) {
                const int vb = (v8 + 8 * i) * 8;
#pragma unroll
                for (int j = 0; j < 4; ++j) { const unsigned w = vv[i][j]; Vt[(vb + 2 * j) * 72 + vs] = (bf16_t)(w & 0xffffu); Vt[(vb + 2 * j + 1) * 72 + vs] = (bf16_t)(w >> 16); }
            }
        }
        {
            const size_t rown = (size_t)row0 + (size_t)(c + 1 < nc ? c + 1 : c) * 64;
            const size_t ub = (rown + 16 * sg) * 512 + h * 128 + kc0;
            const float* gp = zg + ub; const bf16_t* qp = zq + ub; const bf16_t* kp = zk + ub;
#pragma unroll
            for (int i = 0; i < 16; ++i) { gg[i] = gp[i * 512 + lo_e]; qq[i] = qp[i * 512 + lo_e]; kk[i] = kp[i * 512 + lo_e]; }
            const bf16_t* vp = zv + rown * 512 + h * 128 + v8 * 8;
#pragma unroll
            for (int i = 0; i < 2; ++i) vv[i] = *(const u32x4*)(vp + i * 64 + lo_v);
        }
        u32x2 og[4];
        const int trow = 16 * ttile + fr;
        {
            const bf16_t* ogp = zog + (rowc + 16 * ttile) * 512 + h * 128 + 64 * half;
            const unsigned lo_o = (unsigned)fr * 512u + 4u * fq;
#pragma unroll
            for (int i = 0; i < 4; ++i) og[i] = *(const u32x2*)(ogp + 16 * i + lo_o);
        }
        __syncthreads();
        bf16x8 Qf[4];
#pragma unroll
        for (int k4 = 0; k4 < 4; ++k4) Qf[k4] = *(const LAS bf16x8*)(Qs + trow * 136 + 32 * k4 + 8 * fq);
#pragma unroll
        for (int si = 0; si < 2; ++si) {
            const int st = 2 * half + si;
            f32x4 a = (f32x4){0.f, 0.f, 0.f, 0.f};
            if (st <= ttile) {
#pragma unroll
                for (int k4 = 0; k4 < 4; ++k4) { const bf16x8 Kf = *(const LAS bf16x8*)(Ks + (16 * st + fr) * 136 + 32 * k4 + 8 * fq); a = mfma16(Kf, Qf[k4], a); }
#pragma unroll
                for (int r = 0; r < 4; ++r) a[r] = (16 * st + 4 * fq + r <= trow) ? a[r] : 0.f;
            }
            u32x2 w; w.x = cvt_pk_bf16(a[0], a[1]); w.y = cvt_pk_bf16(a[2], a[3]);
            *(LAS u32x2*)(As + trow * 72 + 16 * st + 4 * fq) = w;
        }
        __syncthreads();
        f32x4 Oacc[4];
        {
            bf16x8 Af[2];
#pragma unroll
            for (int k2 = 0; k2 < 2; ++k2) Af[k2] = *(const LAS bf16x8*)(As + trow * 72 + 32 * k2 + 8 * fq);
            float sq = 0.f;
#pragma unroll
            for (int i = 0; i < 4; ++i) {
                const int vrow = 16 * (4 * half + i) + fr;
                f32x4 a = (f32x4){0.f, 0.f, 0.f, 0.f};
#pragma unroll
                for (int k2 = 0; k2 < 2; ++k2) { const bf16x8 Vf = *(const LAS bf16x8*)(Vt + vrow * 72 + 32 * k2 + 8 * fq); a = mfma16(Vf, Af[k2], a); }
#pragma unroll
                for (int k4 = 0; k4 < 4; ++k4) { const bf16x8 Sf = *(const LAS bf16x8*)(St + vrow * 136 + 32 * k4 + 8 * fq); a = mfma16(Sf, Qf[k4], a); }
                Oacc[i] = a;
                sq += a[0] * a[0] + a[1] * a[1] + a[2] * a[2] + a[3] * a[3];
            }
            sq += __shfl_xor(sq, 16); sq += __shfl_xor(sq, 32);
            if (fq == 0) ssq[trow * 2 + half] = sq;
            const f32x4 dk = *(const LAS f32x4*)(dec + 16 * wid + 4 * fq);
            bf16x8 Ktf[2];
#pragma unroll
            for (int k2 = 0; k2 < 2; ++k2) Ktf[k2] = *(const LAS bf16x8*)(Kt + (16 * wid + fr) * 72 + 32 * k2 + 8 * fq);
#pragma unroll
            for (int vt = 0; vt < 8; ++vt) {
                f32x4 s = Sacc[vt] * dk;
#pragma unroll
                for (int k2 = 0; k2 < 2; ++k2) { const bf16x8 Vf = *(const LAS bf16x8*)(Vt + (16 * vt + fr) * 72 + 32 * k2 + 8 * fq); s = mfma16(Ktf[k2], Vf, s); }
                Sacc[vt] = s;
            }
        }
        __syncthreads();
#pragma unroll
        for (int vt = 0; vt < 8; ++vt) {
            u32x2 w; w.x = cvt_pk_bf16(Sacc[vt][0], Sacc[vt][1]); w.y = cvt_pk_bf16(Sacc[vt][2], Sacc[vt][3]);
            *(LAS u32x2*)(St + (16 * vt + fr) * 136 + 16 * wid + 4 * fq) = w;
        }
        {
            const float tots = ssq[trow * 2] + ssq[trow * 2 + 1];
            const float r = rsqrtf(tots * (1.0f / 128.0f) + 1e-6f);
#pragma unroll
            for (int i = 0; i < 4; ++i) {
                const f32x4 gn = *(const f32x4*)(p.g_hgrn + 16 * (4 * half + i) + 4 * fq);
                const float o0 = Oacc[i][0] * r * gn[0] * fsilu(bf_lo(og[i].x)), o1 = Oacc[i][1] * r * gn[1] * fsilu(bf_hi(og[i].x));
                const float o2 = Oacc[i][2] * r * gn[2] * fsilu(bf_lo(og[i].y)), o3 = Oacc[i][3] * r * gn[3] * fsilu(bf_hi(og[i].y));
                u32x2 w; w.x = cvt_pk_bf16(o0, o1); w.y = cvt_pk_bf16(o2, o3);
                *(u32x2*)(ymix + (rowc + 16 * ttile) * DM + h * 128 + 64 * half + 16 * i + ((unsigned)fr * 1024u + 4u * fq)) = w;
            }
        }
    }
#pragma unroll
    for (int vt = 0; vt < 8; ++vt)
#pragma unroll
        for (int r = 0; r < 4; ++r) Sout[(size_t)(16 * wid + 4 * fq + r) * 128 + 16 * vt + fr] = Sacc[vt][r];
    __syncthreads();
}

constexpr int AT_KS = 0, AT_VT = 27648;
__device__ __forceinline__ void attn_unit(const Params& p, int a, LAS unsigned char* lds) {
    const unsigned char* big = p.ws + W_BIG;
    const bf16_t* zsq = (const bf16_t*)(big + Z_SQ); const bf16_t* zsk = (const bf16_t*)(big + Z_SK); const bf16_t* zsv = (const bf16_t*)(big + Z_SV);
    bf16_t* ymix = (bf16_t*)(p.ws + W_H);
    LAS bf16_t* Ks = (LAS bf16_t*)(lds + AT_KS); LAS bf16_t* Vt = (LAS bf16_t*)(lds + AT_VT);
    const int tid = threadIdx.x, wid = tid >> 6, lane = tid & 63, fr = lane & 15, fq = lane >> 4;
    int kvh, jb0; size_t row0; bool sample; int sb = 0, bb = 0, cc = 0;
    if (a < 2048) { bb = a >> 7; cc = (a >> 1) & 63; kvh = a & 1; row0 = (size_t)bb * 4096 + (size_t)cc * 64; jb0 = cc >= 2 ? 0 : 2 - cc; sample = false; }
    else { const int s2 = a - 2048; sb = s2 >> 1; kvh = s2 & 1; row0 = (size_t)TP + (size_t)sb * 64; jb0 = 0; sample = true; }
    __syncthreads();
    for (int jb = jb0; jb < 3; ++jb) {
        const int ks = tid >> 3, kd8 = tid & 7;
        const int vsx = tid & 63, vd8 = tid >> 6;
        u32x4 kw, vw;
        if (sample && jb < 2) {
            const float* kp = p.cache_k + ((size_t)(sb * 128 + jb * 64 + ks) * 2 + kvh) * 64 + kd8 * 8;
            const float* vp = p.cache_v + ((size_t)(sb * 128 + jb * 64 + vsx) * 2 + kvh) * 64 + vd8 * 8;
            const f32x4 k0 = *(const f32x4*)kp, k1 = *(const f32x4*)(kp + 4), v0 = *(const f32x4*)vp, v1 = *(const f32x4*)(vp + 4);
            kw = (u32x4){cvt_pk_bf16(k0[0], k0[1]), cvt_pk_bf16(k0[2], k0[3]), cvt_pk_bf16(k1[0], k1[1]), cvt_pk_bf16(k1[2], k1[3])};
            vw = (u32x4){cvt_pk_bf16(v0[0], v0[1]), cvt_pk_bf16(v0[2], v0[3]), cvt_pk_bf16(v1[0], v1[1]), cvt_pk_bf16(v1[2], v1[3])};
        } else {
            const size_t kr = sample ? row0 : row0 - 128 + (size_t)jb * 64;
            kw = *(const u32x4*)(zsk + (kr + ks) * 128 + kvh * 64 + kd8 * 8);
            vw = *(const u32x4*)(zsv + (kr + vsx) * 128 + kvh * 64 + vd8 * 8);
        }
        *(LAS u32x4*)(Ks + (jb * 64 + ks) * 72 + kd8 * 8) = kw;
#pragma unroll
        for (int j = 0; j < 4; ++j) { const unsigned w = vw[j]; Vt[(vd8 * 8 + 2 * j) * 200 + jb * 64 + vsx] = (bf16_t)(w & 0xffffu); Vt[(vd8 * 8 + 2 * j + 1) * 200 + jb * 64 + vsx] = (bf16_t)(w >> 16); }
    }
    __syncthreads();
#pragma unroll 1
    for (int task = wid; task < 16; task += 8) {
        const int gi = task >> 2, tt = task & 3, hh = kvh * 4 + gi;
        const int t = 16 * tt + fr;
        const float slope = exp2f(-(float)(hh + 1)), sink = p.sinks[hh];
        bf16x8 Qf[2];
#pragma unroll
        for (int kd = 0; kd < 2; ++kd) Qf[kd] = *(const bf16x8*)(zsq + (row0 + t) * 512 + hh * 64 + 32 * kd + 8 * fq);
        f32x4 sc[12];
        float mx = sink;
#pragma unroll
        for (int tile = 0; tile < 12; ++tile) {
            if (tile >= 4 * jb0) {
                f32x4 acc = (f32x4){0.f, 0.f, 0.f, 0.f};
#pragma unroll
                for (int kd = 0; kd < 2; ++kd) { const bf16x8 Kf = *(const LAS bf16x8*)(Ks + (16 * tile + fr) * 72 + 32 * kd + 8 * fq); acc = mfma16(Kf, Qf[kd], acc); }
#pragma unroll
                for (int r = 0; r < 4; ++r) {
                    const int s = 16 * tile + 4 * fq + r;
                    const float d = fabsf((float)(t + 128 - s));
                    acc[r] = acc[r] * 0.125f - slope * d;
                    mx = fmaxf(mx, acc[r]);
                }
                sc[tile] = acc;
            } else sc[tile] = (f32x4){-INFINITY, -INFINITY, -INFINITY, -INFINITY};
        }
        mx = fmaxf(mx, __shfl_xor(mx, 16)); mx = fmaxf(mx, __shfl_xor(mx, 32));
        float l = 0.f;
#pragma unroll
        for (int tile = 0; tile < 12; ++tile)
#pragma unroll
            for (int r = 0; r < 4; ++r) { const float e = __expf(sc[tile][r] - mx); sc[tile][r] = e; l += e; }
        l += __shfl_xor(l, 16); l += __shfl_xor(l, 32);
        l += __expf(sink - mx);
        const float rl = 1.0f / l;
        f32x4 o[4];
#pragma unroll
        for (int dt = 0; dt < 4; ++dt) o[dt] = (f32x4){0.f, 0.f, 0.f, 0.f};
#pragma unroll
        for (int k6 = 0; k6 < 6; ++k6) {
            if (k6 >= 2 * jb0) {
                union { u32x4 u; bf16x8 b; } pf;
                pf.u = (u32x4){cvt_pk_bf16(sc[2 * k6][0], sc[2 * k6][1]), cvt_pk_bf16(sc[2 * k6][2], sc[2 * k6][3]), cvt_pk_bf16(sc[2 * k6 + 1][0], sc[2 * k6 + 1][1]), cvt_pk_bf16(sc[2 * k6 + 1][2], sc[2 * k6 + 1][3])};
#pragma unroll
                for (int dt = 0; dt < 4; ++dt) {
                    union { u32x4 u; bf16x8 b; } vf;
                    const u32x2 lo = *(const LAS u32x2*)(Vt + (16 * dt + fr) * 200 + 32 * k6 + 4 * fq), hi = *(const LAS u32x2*)(Vt + (16 * dt + fr) * 200 + 32 * k6 + 16 + 4 * fq);
                    vf.u = (u32x4){lo.x, lo.y, hi.x, hi.y};
                    o[dt] = mfma16(vf.b, pf.b, o[dt]);
                }
            }
        }
#pragma unroll
        for (int dt = 0; dt < 4; ++dt) {
            u32x2 w; w.x = cvt_pk_bf16(o[dt][0] * rl, o[dt][1] * rl); w.y = cvt_pk_bf16(o[dt][2] * rl, o[dt][3] * rl);
            *(u32x2*)(ymix + (row0 + t) * DM + 512 + hh * 64 + 16 * dt + 4 * fq) = w;
        }
    }
}

__device__ __forceinline__ void mixer_phase(const Params& p, LAS unsigned char* lds) {
    if (blockIdx.x < 64) {
        const int u = blockIdx.x, b = u >> 2, h = u & 3;
#ifndef NO_HGRN
        hgrn_unit(p, b * 4096, 64, h, (const float*)(p.ws + W_ZERO), p.out + O_STP + (size_t)u * 16384, lds);
#endif
    } else {
        const int nb = gridDim.x - 64;
        for (int it = blockIdx.x - 64; it < 128 + 2112; it += nb) {
#ifndef NO_HGRN
            if (it < 128) { const int sb = it >> 2, h = it & 3; hgrn_unit(p, TP + sb * 64, 1, h, p.state + (size_t)it * 16384, p.out + O_STS + (size_t)it * 16384, lds); }
#else
            if (it < 128) {}
#endif
#ifndef NO_ATTN
            else attn_unit(p, it - 128, lds);
#endif
        }
    }
}

__global__ void __launch_bounds__(512, 2) mk_fwd(Params p) {
    extern __shared__ __attribute__((aligned(16))) unsigned char lds_raw[];
    LAS unsigned char* lds = (LAS unsigned char*)lds_raw;
    cg::grid_group grid = cg::this_grid();
    float* mod = (float*)(p.ws + W_MOD);
    bf16_t* hbuf = (bf16_t*)(p.ws + W_H);
    bf16_t* hidden = (bf16_t*)(p.ws + W_BIG);
    float* xres = p.out + O_Y;
    pg8::StaticOrder so;
#ifndef PH_MASK
#define PH_MASK 0xFFF
#endif
#define PHASE_BEGIN(i) if (((PH_MASK >> (i)) & 1) && p.ph_lo <= (i) && (i) < p.ph_hi) { if ((i) > p.ph_lo) grid.sync();
#define PHASE_END }
    PHASE_BEGIN(0) phase0(p, lds); PHASE_END
    PHASE_BEGIN(1) norm_mod_phase(p.x_p, p.x_s, p.g_ffn1, mod, 0, 1, hbuf); PHASE_END
    PHASE_BEGIN(2) { so.init(T, 2 * DFF, gridDim.x, blockIdx.x); pg8::Gemm g{hbuf, (const bf16_t*)(p.ws + W_UP1), T, 2 * DFF, DM}; EpiSwiglu e{hidden}; pg8::gemm_phase(lds, g, so, e); } PHASE_END
    PHASE_BEGIN(3) { so.init(T, DM, gridDim.x, blockIdx.x); pg8::Gemm g{hidden, (const bf16_t*)(p.ws + W_DN1), T, DM, DFF}; EpiResid e{p.x_p, p.x_s, xres, mod + 2 * DM, 0.5f}; pg8::gemm_phase(lds, g, so, e); } PHASE_END
    PHASE_BEGIN(4) norm_mod_phase(xres, xres + (size_t)TP * DM, p.g_mix, mod, 3, 4, hbuf); PHASE_END
    PHASE_BEGIN(5) { so.init(T, DIN, gridDim.x, blockIdx.x); pg8::Gemm g{hbuf, (const bf16_t*)(p.ws + W_IN), T, DIN, DM}; EpiInproj e{p.ws + W_BIG, p.lb_logits, p.out}; pg8::gemm_phase(lds, g, so, e); } PHASE_END
    PHASE_BEGIN(6) mixer_phase(p, lds); PHASE_END
    PHASE_BEGIN(7) { so.init(T, DM, gridDim.x, blockIdx.x); pg8::Gemm g{hbuf, (const bf16_t*)(p.ws + W_OUT), T, DM, DM}; EpiResid e{xres, xres + (size_t)TP * DM, xres, mod + 5 * DM, 1.0f}; pg8::gemm_phase(lds, g, so, e); } PHASE_END
    PHASE_BEGIN(8) norm_mod_phase(xres, xres + (size_t)TP * DM, p.g_ffn2, mod, 6, 7, hbuf); PHASE_END
    PHASE_BEGIN(9) { so.init(T, 2 * DFF, gridDim.x, blockIdx.x); pg8::Gemm g{hbuf, (const bf16_t*)(p.ws + W_UP2), T, 2 * DFF, DM}; EpiSwiglu e{hidden}; pg8::gemm_phase(lds, g, so, e); } PHASE_END
    PHASE_BEGIN(10) { so.init(T, DM, gridDim.x, blockIdx.x); pg8::Gemm g{hidden, (const bf16_t*)(p.ws + W_DN2), T, DM, DFF}; EpiResid e{xres, xres + (size_t)TP * DM, xres, mod + 8 * DM, 0.5f}; pg8::gemm_phase(lds, g, so, e); } PHASE_END
    PHASE_BEGIN(11) final_norm_phase(xres, p.g_final); PHASE_END
}

extern "C" void kernel_launch(void* const* d_in, const int* in_sizes, int n_in, void* d_out, int out_size, void* d_ws, size_t ws_size, hipStream_t stream) {
    static int grid_blocks = 0;
    if (!grid_blocks) {
        int dev = 0, cus = 0, per_cu = 0;
        hipGetDevice(&dev);
        hipDeviceGetAttribute(&cus, hipDeviceAttributeMultiprocessorCount, dev);
        hipFuncSetAttribute((const void*)mk_fwd, hipFuncAttributeMaxDynamicSharedMemorySize, LDS_BYTES);
        hipOccupancyMaxActiveBlocksPerMultiprocessor(&per_cu, (const void*)mk_fwd, 512, LDS_BYTES);
        if (per_cu < 1) per_cu = 1;
        grid_blocks = cus * per_cu;
        if (grid_blocks > 256) grid_blocks = 256;
        if (ws_size < WS_NEED) fprintf(stderr, "kernel_launch: workspace too small: %zu < %zu\n", ws_size, (size_t)WS_NEED);
    }
    Params p{};
    const float** pp = (const float**)&p;
    for (int i = 0; i < 22; ++i) pp[i] = (const float*)d_in[i];
    p.out = (float*)d_out; p.ws = (unsigned char*)d_ws;
#if MK_LAUNCHES == 1
    p.ph_lo = 0; p.ph_hi = NPHASE;
    void* args[] = {&p};
    hipError_t e = hipLaunchCooperativeKernel((const void*)mk_fwd, dim3(grid_blocks), dim3(512), args, LDS_BYTES, stream);
    if (e != hipSuccess) fprintf(stderr, "cooperative launch failed: %s (grid %d)\n", hipGetErrorString(e), grid_blocks);
#else
    for (int i = 0; i < NPHASE; ++i) { p.ph_lo = i; p.ph_hi = i + 1; hipLaunchKernelGGL(mk_fwd, dim3(grid_blocks), dim3(512), LDS_BYTES, stream, p); }
#endif
}
```

```cpp
#include <hip/hip_runtime.h>
#include <hip/hip_cooperative_groups.h>
#include <cstdio>
namespace cg = cooperative_groups;

#ifndef MK_LAUNCHES
#define MK_LAUNCHES 1
#endif

#define LAS __attribute__((address_space(3)))
typedef unsigned short bf16_t;
typedef short bf16x8 __attribute__((ext_vector_type(8)));
typedef float f32x4 __attribute__((ext_vector_type(4)));
typedef unsigned u32x4 __attribute__((ext_vector_type(4)));
typedef unsigned u32x2 __attribute__((ext_vector_type(2)));

constexpr int TP = 65536, TS = 2048, T = TP + TS, DM = 1024, DFF = 2816, DIN = 2816, NB = 48, NMOD = 9216;
constexpr int LDS_BYTES = 131072 + 8192;
constexpr int NPHASE = 13;

constexpr size_t O_Y = 0, O_STP = (size_t)T * DM, O_CKP = O_STP + 16 * 4 * 16384, O_CVP = O_CKP + 16 * 16384, O_STS = O_CVP + 16 * 16384,
                 O_CKS = O_STS + 32 * 4 * 16384, O_CVS = O_CKS + 32 * 16384;
constexpr size_t W_UP1 = 0, W_DN1 = W_UP1 + (size_t)2 * DFF * DM * 2, W_IN = W_DN1 + (size_t)DM * DFF * 2, W_OUT = W_IN + (size_t)DIN * DM * 2,
                 W_UP2 = W_OUT + (size_t)DM * DM * 2, W_DN2 = W_UP2 + (size_t)2 * DFF * DM * 2, W_MOD = W_DN2 + (size_t)DM * DFF * 2,
                 W_ZERO = W_MOD + (size_t)NB * NMOD * 4, W_H = W_ZERO + 65536, W_BIG = W_H + (size_t)T * DM * 2;
constexpr size_t Z_Q = 0, Z_K = Z_Q + (size_t)T * 512 * 2, Z_V = Z_K + (size_t)T * 512 * 2, Z_OG = Z_V + (size_t)T * 512 * 2, Z_SQ = Z_OG + (size_t)T * 512 * 2,
                 Z_G = Z_SQ + (size_t)T * 512 * 2, Z_SK = Z_G + (size_t)T * 512 * 4, Z_SV = Z_SK + (size_t)T * 128 * 2, Z_END = Z_SV + (size_t)T * 128 * 2;
constexpr size_t W_SSEG = W_BIG + Z_END, W_DSEG = W_SSEG + (size_t)64 * 4 * 16384 * 4, WS_NEED = W_DSEG + (size_t)64 * 4 * 128 * 4;

struct Params {
    const float *x_p, *x_s, *state, *cache_k, *cache_v, *c_p, *c_s, *w_ada, *b_ada, *g_ffn1, *w_up1, *w_down1, *g_mix, *w_in, *lb_logits, *g_hgrn, *sinks, *w_out,
        *g_ffn2, *w_up2, *w_down2, *g_final;
    float* out;
    unsigned char* ws;
    int ph_lo, ph_hi;
};

typedef float f32x2 __attribute__((ext_vector_type(2)));
typedef __bf16 bf16x2_t __attribute__((ext_vector_type(2)));
__device__ __forceinline__ unsigned cvt_pk_bf16(float lo, float hi) { const f32x2 v = {lo, hi}; return __builtin_bit_cast(unsigned, __builtin_convertvector(v, bf16x2_t)); }
__device__ __forceinline__ float bf_lo(unsigned w) { return __uint_as_float(w << 16); }
__device__ __forceinline__ float bf_hi(unsigned w) { return __uint_as_float(w & 0xffff0000u); }
__device__ __forceinline__ float bf2f(bf16_t b) { return __uint_as_float(((unsigned)b) << 16); }
__device__ __forceinline__ float fsilu(float v) { return v * __builtin_amdgcn_rcpf(1.0f + __expf(-v)); }
__device__ __forceinline__ int batch_of_row(int row) { return row < TP ? (row >> 12) : 16 + ((row - TP) >> 6); }

namespace pg8 {
constexpr int BM = 256, BK = 64, HALF = 128, HTB = HALF * BK * 2, STAGE_BYTES = 8 * HTB, NXCD = 8, WGM = 8;
__device__ __forceinline__ int lds_byte(int r, int c) { const int st = (r >> 4) * 2 + (c >> 5), rr = r & 15, cc = c & 31, ob = rr * 64 + cc * 2; return st * 1024 + (ob ^ (((ob >> 9) & 1) << 5)); }
__device__ __forceinline__ void stage_rc(int b, int& R, int& C) { const int st = b / 1024, sb = b % 1024, swz = sb ^ (((sb >> 9) & 1) << 5); R = (st >> 1) * 16 + swz / 64; C = (st & 1) * 32 + (swz % 64) / 2; }
__device__ __forceinline__ int perm32(int rho) { const int n = rho >> 4, i = rho & 15; return 8 * (i >> 2) + 4 * n + (i & 3); }
struct Unit { int pm, pn; };
struct Gemm { const bf16_t* A; const bf16_t* Bt; int M, N, K; };
struct StaticOrder {
    int nM, nN, nwg, G, c;
    __device__ void init(int M, int N, int G_, int c_) { nM = M / BM; nN = N / BM; nwg = nM * nN; G = G_; c = c_; }
    __device__ bool next(int i, Unit& u) const {
        const long L = (long)i * G + c; if (L >= nwg) return false;
        int wgid = (int)L; { const int q = nwg / NXCD, r = nwg % NXCD, xcd = wgid % NXCD, off = wgid / NXCD; wgid = (xcd < r ? xcd * (q + 1) : r * (q + 1) + (xcd - r) * q) + off; }
        const int nig = WGM * nN, gid = wgid / nig, fm = gid * WGM, gsz = (nM - fm) < WGM ? (nM - fm) : WGM;
        u.pm = fm + ((wgid % nig) % gsz); u.pn = (wgid % nig) / gsz; return true;
    }
};

template <class Epi>
__device__ __forceinline__ void gemm_phase(LAS unsigned char* lds, const Gemm g, const StaticOrder& S, const Epi& E) {
    const int tid = threadIdx.x, wid = __builtin_amdgcn_readfirstlane(tid >> 6), lane = tid & 63, wr = wid >> 2, wc = wid & 3, fr = lane & 15, fq = lane >> 4;
    const int K = g.K, nt = K / BK;
    unsigned voffA[2], voffB[2];
#pragma unroll
    for (int i = 0; i < 2; ++i) { int R, C; stage_rc(tid * 16 + i * 8192, R, C); const int Rb = Epi::PERM ? ((R & ~31) + perm32(R & 31)) : R;
        voffA[i] = (unsigned)(R * K + C) * 2u; voffB[i] = (unsigned)(Rb * K + C) * 2u; }
    const size_t kstep = (size_t)(BK * 2);
    const size_t hstep = (size_t)HALF * K * 2;
    const size_t tstep = 2 * hstep;
    const unsigned ldsw = (unsigned)wid * 1024u;
    const int aoff = lds_byte(wr * 64 + fr, fq * 8), boff = lds_byte(wc * 32 + fr, fq * 8);
#define PG8_SA(b, h) (((b) * 2 + (h)) * HTB)
#define PG8_SB(b, h) ((4 + (b) * 2 + (h)) * HTB)
#define PG8_STAGE(bufoff, gbase, voff) do { _Pragma("unroll") for (int _i = 0; _i < 2; ++_i) \
        __builtin_amdgcn_global_load_lds((const unsigned*)((const char*)(gbase) + (voff)[_i]), (LAS unsigned*)(lds + (bufoff) + ldsw + _i * 8192), 16, 0, 0); } while (0)
#define PG8_LDA(dst, b, h) do { _Pragma("unroll") for (int m = 0; m < 4; ++m) _Pragma("unroll") for (int k = 0; k < 2; ++k) dst[m][k] = *(const LAS bf16x8*)(lds + PG8_SA(b, h) + aoff + m * 2048 + k * 1024); } while (0)
#define PG8_LDB(dst, b, h) do { _Pragma("unroll") for (int n = 0; n < 2; ++n) _Pragma("unroll") for (int k = 0; k < 2; ++k) dst[n][k] = *(const LAS bf16x8*)(lds + PG8_SB(b, h) + boff + n * 2048 + k * 1024); } while (0)
#define PG8_MMA(ai, bj, At, Bt) do { __builtin_amdgcn_s_setprio(1); _Pragma("unroll") for (int m = 0; m < 4; ++m) _Pragma("unroll") for (int n = 0; n < 2; ++n) _Pragma("unroll") for (int k = 0; k < 2; ++k) \
        acc[ai][bj][m][n] = __builtin_amdgcn_mfma_f32_16x16x32_bf16(Bt[n][k], At[m][k], acc[ai][bj][m][n], 0, 0, 0); __builtin_amdgcn_s_setprio(0); } while (0)
#define PG8_WAIT_V(n) asm volatile("s_waitcnt vmcnt(" #n ")" ::: "memory")
#define PG8_WAIT_L(n) asm volatile("s_waitcnt lgkmcnt(" #n ")" ::: "memory")
#define PG8_BAR __builtin_amdgcn_s_barrier()
#define PG8_SCHED __builtin_amdgcn_sched_barrier(0)
    Unit cur, nxt; int ui = 0;
    if (!S.next(0, cur)) return;
    f32x4 acc[2][2][4][2];
#pragma unroll
    for (int a = 0; a < 2; ++a)
#pragma unroll
        for (int b = 0; b < 2; ++b)
#pragma unroll
            for (int m = 0; m < 4; ++m)
#pragma unroll
                for (int n = 0; n < 2; ++n) acc[a][b][m][n] = (f32x4){0.f, 0.f, 0.f, 0.f};
    bf16x8 At[4][2], B0[2][2], B1[2][2];
    const char* cA = (const char*)g.A + (size_t)cur.pm * tstep; const char* cB = (const char*)g.Bt + (size_t)cur.pn * tstep;
    PG8_STAGE(PG8_SB(0, 0), cB, voffB); PG8_STAGE(PG8_SA(0, 0), cA, voffA); PG8_STAGE(PG8_SB(0, 1), cB + hstep, voffB); PG8_STAGE(PG8_SA(0, 1), cA + hstep, voffA);
    if (wr == 1) PG8_BAR;
    PG8_WAIT_V(4); PG8_BAR;
    PG8_STAGE(PG8_SB(1, 0), cB + kstep, voffB); PG8_STAGE(PG8_SA(1, 0), cA + kstep, voffA); PG8_STAGE(PG8_SB(1, 1), cB + hstep + kstep, voffB);
    PG8_WAIT_V(6); PG8_BAR;
    for (;;) {
        const bool has_next = S.next(ui + 1, nxt);
        const char* nA = has_next ? (const char*)g.A + (size_t)nxt.pm * tstep : cA; const char* nB = has_next ? (const char*)g.Bt + (size_t)nxt.pn * tstep : cB;
        for (int t = 0; t < nt; t += 2) {
            const bool last = (t == nt - 2);
            const char* a1 = cA + (size_t)(t + 1) * kstep;
            const char* a2 = last ? nA : cA + (size_t)(t + 2) * kstep; const char* b2 = last ? nB : cB + (size_t)(t + 2) * kstep;
            const char* a3 = a2 + kstep; const char* b3 = b2 + kstep;
            PG8_LDB(B0, 0, 0); PG8_SCHED; PG8_LDA(At, 0, 0); PG8_STAGE(PG8_SA(1, 1), a1 + hstep, voffA);
            PG8_WAIT_L(8); PG8_BAR; PG8_WAIT_L(0); PG8_MMA(0, 0, At, B0); PG8_BAR; PG8_SCHED;
            PG8_LDB(B1, 0, 1); PG8_STAGE(PG8_SB(0, 0), b2, voffB);
            PG8_BAR; PG8_WAIT_L(0); PG8_MMA(0, 1, At, B1); PG8_BAR;
            PG8_LDA(At, 0, 1); PG8_STAGE(PG8_SA(0, 0), a2, voffA);
            PG8_BAR; PG8_WAIT_L(0); PG8_MMA(1, 0, At, B0); PG8_BAR; PG8_SCHED;
            PG8_STAGE(PG8_SB(0, 1), b2 + hstep, voffB);
            PG8_WAIT_V(6); PG8_BAR; PG8_MMA(1, 1, At, B1); PG8_BAR;
            PG8_LDB(B0, 1, 0); PG8_SCHED; PG8_LDA(At, 1, 0); PG8_STAGE(PG8_SA(0, 1), a2 + hstep, voffA);
            PG8_WAIT_L(8); PG8_BAR; PG8_WAIT_L(0); PG8_MMA(0, 0, At, B0); PG8_BAR; PG8_SCHED;
            PG8_LDB(B1, 1, 1); PG8_STAGE(PG8_SB(1, 0), b3, voffB);
            PG8_BAR; PG8_WAIT_L(0); PG8_MMA(0, 1, At, B1); PG8_BAR;
            PG8_LDA(At, 1, 1); PG8_STAGE(PG8_SA(1, 0), a3, voffA);
            PG8_BAR; PG8_WAIT_L(0); PG8_MMA(1, 0, At, B0); PG8_BAR; PG8_SCHED;
            PG8_STAGE(PG8_SB(1, 1), b3 + hstep, voffB);
            PG8_WAIT_V(6); PG8_BAR; PG8_MMA(1, 1, At, B1); PG8_BAR;
        }
        E(acc, cur, wr, wc, fr, fq);
        if (!has_next) break;
#pragma unroll
        for (int a = 0; a < 2; ++a)
#pragma unroll
            for (int b = 0; b < 2; ++b)
#pragma unroll
                for (int m = 0; m < 4; ++m)
#pragma unroll
                    for (int n = 0; n < 2; ++n) acc[a][b][m][n] = (f32x4){0.f, 0.f, 0.f, 0.f};
        cur = nxt; cA = nA; cB = nB; ++ui;
    }
    PG8_WAIT_V(0);
    if (wr == 0) PG8_BAR;
    PG8_BAR;
#undef PG8_SA
#undef PG8_SB
#undef PG8_STAGE
#undef PG8_LDA
#undef PG8_LDB
#undef PG8_MMA
#undef PG8_WAIT_V
#undef PG8_WAIT_L
#undef PG8_BAR
#undef PG8_SCHED
}
}
using pg8::Unit;

struct EpiSwiglu {
    static constexpr bool PERM = true;
    bf16_t* H;
    __device__ __forceinline__ void operator()(const f32x4 (&acc)[2][2][4][2], const Unit& u, int wr, int wc, int fr, int fq) const {
        const int row0 = u.pm * 256 + wr * 64 + fr, col0 = u.pn * 128 + wc * 32 + 8 * fq;
#pragma unroll
        for (int ai = 0; ai < 2; ++ai)
#pragma unroll
            for (int m = 0; m < 4; ++m) {
                bf16_t* rowp = H + (size_t)(row0 + ai * 128 + m * 16) * DFF + col0;
                float v[8];
#pragma unroll
                for (int n = 0; n < 2; ++n)
#pragma unroll
                    for (int j = 0; j < 4; ++j) v[n * 4 + j] = fsilu(acc[ai][0][m][n][j]) * acc[ai][1][m][n][j];
                u32x4 w; w.x = cvt_pk_bf16(v[0], v[1]); w.y = cvt_pk_bf16(v[2], v[3]); w.z = cvt_pk_bf16(v[4], v[5]); w.w = cvt_pk_bf16(v[6], v[7]);
                *(u32x4*)rowp = w;
            }
    }
};
struct EpiResid {
    static constexpr bool PERM = false;
    const float* xa; const float* xb; float* out; const float* gate; float coef;
    __device__ __forceinline__ void operator()(const f32x4 (&acc)[2][2][4][2], const Unit& u, int wr, int wc, int fr, int fq) const {
        const int col0 = u.pn * 256 + wc * 32 + 4 * fq;
#pragma unroll
        for (int ai = 0; ai < 2; ++ai) {
            const int b = u.pm < 256 ? (u.pm >> 4) : 16 + (u.pm - 256) * 4 + ai * 2 + wr;
            const float* gp = gate + (size_t)b * NMOD + col0;
            f32x4 gv[2][2];
#pragma unroll
            for (int bj = 0; bj < 2; ++bj)
#pragma unroll
                for (int n = 0; n < 2; ++n) gv[bj][n] = *(const f32x4*)(gp + bj * 128 + n * 16) * coef;
#pragma unroll
            for (int m = 0; m < 4; ++m) {
                const int row = u.pm * 256 + ai * 128 + wr * 64 + m * 16 + fr;
                const float* bp = (row < TP ? xa + (size_t)row * DM : xb + (size_t)(row - TP) * DM) + col0;
                float* op = out + (size_t)row * DM + col0;
#pragma unroll
                for (int bj = 0; bj < 2; ++bj)
#pragma unroll
                    for (int n = 0; n < 2; ++n) { const f32x4 x = *(const f32x4*)(bp + bj * 128 + n * 16); *(f32x4*)(op + bj * 128 + n * 16) = x + gv[bj][n] * acc[ai][bj][m][n]; }
            }
        }
    }
};
struct EpiInproj {
    static constexpr bool PERM = true;
    unsigned char* big; const float* lbl; float* out;
    __device__ __forceinline__ void store8(bf16_t* p, const f32x4& a, const f32x4& b) const {
        u32x4 w; w.x = cvt_pk_bf16(a[0], a[1]); w.y = cvt_pk_bf16(a[2], a[3]); w.z = cvt_pk_bf16(b[0], b[1]); w.w = cvt_pk_bf16(b[2], b[3]); *(u32x4*)p = w;
    }
    __device__ __forceinline__ void operator()(const f32x4 (&acc)[2][2][4][2], const Unit& u, int wr, int wc, int fr, int fq) const {
        const int row0 = u.pm * 256 + wr * 64 + fr, cw = wc * 32 + 8 * fq;
        const int pn = u.pn;
        if (pn == 2 || pn == 3) {
            bf16_t* zk = (bf16_t*)(big + Z_K); float* zg = (float*)(big + Z_G);
#pragma unroll
            for (int bj = 0; bj < 2; ++bj) {
                const int cc = (pn - 2) * 256 + bj * 128 + cw;
                float lb[8];
#pragma unroll
                for (int j = 0; j < 8; ++j) lb[j] = 1.0f / (1.0f + expf(lbl[512 + cc + j] - lbl[cc + j]));
#pragma unroll
                for (int ai = 0; ai < 2; ++ai)
#pragma unroll
                    for (int m = 0; m < 4; ++m) {
                        const size_t row = (size_t)(row0 + ai * 128 + m * 16);
                        f32x4 kk[2], gg[2];
#pragma unroll
                        for (int n = 0; n < 2; ++n)
#pragma unroll
                            for (int j = 0; j < 4; ++j) {
                                const float f = acc[ai][bj][m][n][j], l = lb[n * 4 + j];
                                const float e = __expf(-f), sg = 1.0f / (1.0f + e);
                                const float forget = l + (1.0f - l) * sg;
                                kk[n][j] = (1.0f - l) * (1.0f - sg);
                                gg[n][j] = logf(forget);
                            }
                        store8(zk + row * 512 + cc, kk[0], kk[1]);
                        *(f32x4*)(zg + row * 512 + cc) = gg[0]; *(f32x4*)(zg + row * 512 + cc + 4) = gg[1];
                    }
            }
        } else if (pn == 10) {
#pragma unroll
            for (int bj = 0; bj < 2; ++bj) {
                bf16_t* z = (bf16_t*)(big + (bj ? Z_SV : Z_SK));
#pragma unroll
                for (int ai = 0; ai < 2; ++ai) {
                    float* cp = nullptr;
                    if (u.pm < 256) { if ((u.pm & 15) == 15 && ai == 1) cp = out + (bj ? O_CVP : O_CKP) + (size_t)(u.pm >> 4) * 16384 + (size_t)(wr * 64) * 128; }
                    else cp = out + (bj ? O_CVS : O_CKS) + (size_t)((u.pm - 256) * 4 + ai * 2 + wr) * 16384 + (size_t)64 * 128;
#pragma unroll
                    for (int m = 0; m < 4; ++m) {
                        const size_t row = (size_t)(row0 + ai * 128 + m * 16);
                        store8(z + row * 128 + cw, acc[ai][bj][m][0], acc[ai][bj][m][1]);
                        if (cp) { float* q = cp + (size_t)(m * 16 + fr) * 128 + cw; *(f32x4*)q = acc[ai][bj][m][0]; *(f32x4*)(q + 4) = acc[ai][bj][m][1]; }
                    }
                }
            }
        } else {
            const bool isq = pn < 2 || pn == 6 || pn == 7;
            const size_t zoff = pn < 2 ? Z_Q : (pn < 6 ? Z_V : (pn < 8 ? Z_OG : Z_SQ));
            const int cbase = (pn & 1) * 256;
            bf16_t* z = (bf16_t*)(big + zoff);
#pragma unroll
            for (int bj = 0; bj < 2; ++bj)
#pragma unroll
                for (int ai = 0; ai < 2; ++ai)
#pragma unroll
                    for (int m = 0; m < 4; ++m) {
                        const size_t row = (size_t)(row0 + ai * 128 + m * 16);
                        f32x4 a = acc[ai][bj][m][0], b = acc[ai][bj][m][1];
                        if (isq) {
#pragma unroll
                            for (int j = 0; j < 4; ++j) { a[j] = fsilu(a[j]); b[j] = fsilu(b[j]); }
                        }
                        store8(z + row * 512 + cbase + bj * 128 + cw, a, b);
                    }
        }
    }
};

__device__ __forceinline__ void cvt_tile(const float* src, bf16_t* dst, int K, int N, int mode, int tile, LAS float* tl) {
    const int tid = threadIdx.x;
    const int ntn = N >> 6, tk = tile / ntn, tn = tile - tk * ntn, k0 = tk * 64, n0 = tn * 64;
#pragma unroll
    for (int i = 0; i < 2; ++i) {
        const int r = (tid >> 4) + 32 * i, c4 = (tid & 15) * 4;
        const f32x4 v = *(const f32x4*)(src + (size_t)(k0 + r) * N + n0 + c4);
        tl[r * 65 + c4 + 0] = v[0]; tl[r * 65 + c4 + 1] = v[1]; tl[r * 65 + c4 + 2] = v[2]; tl[r * 65 + c4 + 3] = v[3];
    }
    __syncthreads();
    const int n = tid >> 3, kq = tid & 7;
    float v[8];
#pragma unroll
    for (int j = 0; j < 8; ++j) v[j] = tl[(kq * 8 + j) * 65 + n];
    int nd = n0 + n;
    if (mode == 1) { if (nd < DFF) nd = 256 * (nd >> 7) + (nd & 127); else { const int uu = nd - DFF; nd = 256 * (uu >> 7) + 128 + (uu & 127); } }
    u32x4 w; w.x = cvt_pk_bf16(v[0], v[1]); w.y = cvt_pk_bf16(v[2], v[3]); w.z = cvt_pk_bf16(v[4], v[5]); w.w = cvt_pk_bf16(v[6], v[7]);
    *(u32x4*)(dst + (size_t)nd * K + k0 + kq * 8) = w;
    __syncthreads();
}

__device__ __forceinline__ void adaln_strip(const Params& p, int strip, LAS unsigned char* lds) {
    LAS float* sc = (LAS float*)lds;
    const int tid = threadIdx.x, col = tid & 63, kg = tid >> 6;
    float acc[NB];
#pragma unroll
    for (int b = 0; b < NB; ++b) acc[b] = 0.f;
    for (int ch = 0; ch < 4; ++ch) {
        __syncthreads();
        for (int e = tid; e < NB * 256; e += 512) {
            const int b = e >> 8, kk = e & 255;
            const float c = b < 16 ? p.c_p[b * DM + ch * 256 + kk] : p.c_s[(b - 16) * DM + ch * 256 + kk];
            sc[kk * NB + b] = c / (1.0f + expf(-c));
        }
        __syncthreads();
        for (int kk = 0; kk < 32; ++kk) {
            const int kl = kg * 32 + kk, k = ch * 256 + kl;
            const float w = p.w_ada[(size_t)k * NMOD + strip * 64 + col];
            const LAS f32x4* s4 = (const LAS f32x4*)(sc + kl * NB);
#pragma unroll
            for (int b4 = 0; b4 < NB / 4; ++b4) { const f32x4 s = s4[b4]; acc[4 * b4] += s[0] * w; acc[4 * b4 + 1] += s[1] * w; acc[4 * b4 + 2] += s[2] * w; acc[4 * b4 + 3] += s[3] * w; }
        }
    }
    __syncthreads();
    LAS float* red = (LAS float*)lds;
#pragma unroll
    for (int b = 0; b < NB; ++b) red[(kg * NB + b) * 64 + col] = acc[b];
    __syncthreads();
    float* mod = (float*)(p.ws + W_MOD);
    for (int e = tid; e < NB * 64; e += 512) {
        const int b = e >> 6, c = e & 63;
        float s = 0.f;
#pragma unroll
        for (int g = 0; g < 8; ++g) s += red[(g * NB + b) * 64 + c];
        mod[(size_t)b * NMOD + strip * 64 + c] = s + p.b_ada[strip * 64 + c];
    }
    __syncthreads();
}

__device__ __forceinline__ void phase0(const Params& p, LAS unsigned char* lds) {
    if (blockIdx.x < 144) adaln_strip(p, blockIdx.x, lds);
    {
        const size_t n4 = (size_t)32 * 64 * 128 / 4;
        for (size_t i = (size_t)blockIdx.x * 512 + threadIdx.x; i < 2 * n4; i += (size_t)gridDim.x * 512) {
            const int which = i >= n4; const size_t j = which ? i - n4 : i;
            const size_t sb = j / 2048, r = j % 2048;
            const f32x4 v = *(const f32x4*)((which ? p.cache_v : p.cache_k) + sb * 16384 + 8192 + r * 4);
            *(f32x4*)(p.out + (which ? O_CVS : O_CKS) + sb * 16384 + r * 4) = v;
        }
    }
    for (int i = blockIdx.x * 512 + threadIdx.x; i < 16384; i += gridDim.x * 512) ((float*)(p.ws + W_ZERO))[i] = 0.f;
    LAS float* tl = (LAS float*)lds;
    for (int t = blockIdx.x; t < 5184; t += gridDim.x) {
        if (t < 1408) cvt_tile(p.w_up1, (bf16_t*)(p.ws + W_UP1), DM, 2 * DFF, 1, t, tl);
        else if (t < 2112) cvt_tile(p.w_down1, (bf16_t*)(p.ws + W_DN1), DFF, DM, 0, t - 1408, tl);
        else if (t < 2816) cvt_tile(p.w_in, (bf16_t*)(p.ws + W_IN), DM, DIN, 0, t - 2112, tl);
        else if (t < 3072) cvt_tile(p.w_out, (bf16_t*)(p.ws + W_OUT), DM, DM, 0, t - 2816, tl);
        else if (t < 4480) cvt_tile(p.w_up2, (bf16_t*)(p.ws + W_UP2), DM, 2 * DFF, 1, t - 3072, tl);
        else cvt_tile(p.w_down2, (bf16_t*)(p.ws + W_DN2), DFF, DM, 0, t - 4480, tl);
    }
}

__device__ __forceinline__ float wave_sum(float v) {
#pragma unroll
    for (int o = 32; o > 0; o >>= 1) v += __shfl_xor(v, o);
    return v;
}
__device__ __forceinline__ void norm_mod_row(const f32x4 (&v)[4], const float* gvec, const float* mrow, int shift_idx, int scale_idx, bf16_t* hrow, int lane) {
    float ss = 0.f;
#pragma unroll
    for (int i = 0; i < 4; ++i) ss += v[i][0] * v[i][0] + v[i][1] * v[i][1] + v[i][2] * v[i][2] + v[i][3] * v[i][3];
    ss = wave_sum(ss);
    const float rstd = rsqrtf(ss * (1.0f / DM) + 1e-6f);
#pragma unroll
    for (int i = 0; i < 2; ++i) {
        const int c0 = i * 512 + lane * 8;
        float y[8];
#pragma unroll
        for (int q = 0; q < 2; ++q) {
            const f32x4 g = *(const f32x4*)(gvec + c0 + 4 * q), sc = *(const f32x4*)(mrow + scale_idx * DM + c0 + 4 * q), sh = *(const f32x4*)(mrow + shift_idx * DM + c0 + 4 * q);
#pragma unroll
            for (int j = 0; j < 4; ++j) y[4 * q + j] = v[2 * i + q][j] * rstd * g[j] * (1.0f + sc[j]) + sh[j];
        }
        u32x4 w; w.x = cvt_pk_bf16(y[0], y[1]); w.y = cvt_pk_bf16(y[2], y[3]); w.z = cvt_pk_bf16(y[4], y[5]); w.w = cvt_pk_bf16(y[6], y[7]);
        *(u32x4*)(hrow + c0) = w;
    }
}
__device__ __forceinline__ void norm_mod_phase(const float* xa, const float* xb, const float* gvec, const float* mod, int shift_idx, int scale_idx, bf16_t* h) {
    const int wid = threadIdx.x >> 6, lane = threadIdx.x & 63, stride = gridDim.x * 8;
    for (int row = blockIdx.x * 8 + wid; row < T; row += 2 * stride) {
        const int row2 = row + stride; const bool has2 = row2 < T; const int r2 = has2 ? row2 : row;
        const float* s1 = row < TP ? xa + (size_t)row * DM : xb + (size_t)(row - TP) * DM;
        const float* s2 = r2 < TP ? xa + (size_t)r2 * DM : xb + (size_t)(r2 - TP) * DM;
        f32x4 v1[4], v2[4];
#pragma unroll
        for (int i = 0; i < 2; ++i) { v1[2 * i] = *(const f32x4*)(s1 + i * 512 + lane * 8); v1[2 * i + 1] = *(const f32x4*)(s1 + i * 512 + lane * 8 + 4); }
#pragma unroll
        for (int i = 0; i < 2; ++i) { v2[2 * i] = *(const f32x4*)(s2 + i * 512 + lane * 8); v2[2 * i + 1] = *(const f32x4*)(s2 + i * 512 + lane * 8 + 4); }
        norm_mod_row(v1, gvec, mod + (size_t)batch_of_row(row) * NMOD, shift_idx, scale_idx, h + (size_t)row * DM, lane);
        if (has2) norm_mod_row(v2, gvec, mod + (size_t)batch_of_row(r2) * NMOD, shift_idx, scale_idx, h + (size_t)r2 * DM, lane);
    }
}
__device__ __forceinline__ void final_norm_phase(float* x, const float* gvec) {
    const int wid = threadIdx.x >> 6, lane = threadIdx.x & 63, stride = gridDim.x * 8;
    for (int row = blockIdx.x * 8 + wid; row < T; row += 2 * stride) {
        const int row2 = row + stride; const bool has2 = row2 < T; const int r2 = has2 ? row2 : row;
        float* s1 = x + (size_t)row * DM; float* s2 = x + (size_t)r2 * DM;
        f32x4 v1[4], v2[4];
#pragma unroll
        for (int i = 0; i < 4; ++i) v1[i] = *(const f32x4*)(s1 + i * 256 + lane * 4);
#pragma unroll
        for (int i = 0; i < 4; ++i) v2[i] = *(const f32x4*)(s2 + i * 256 + lane * 4);
        float ss1 = 0.f, ss2 = 0.f;
#pragma unroll
        for (int i = 0; i < 4; ++i) { ss1 += v1[i][0] * v1[i][0] + v1[i][1] * v1[i][1] + v1[i][2] * v1[i][2] + v1[i][3] * v1[i][3]; ss2 += v2[i][0] * v2[i][0] + v2[i][1] * v2[i][1] + v2[i][2] * v2[i][2] + v2[i][3] * v2[i][3]; }
        ss1 = wave_sum(ss1); ss2 = wave_sum(ss2);
        const float r1 = rsqrtf(ss1 * (1.0f / DM) + 1e-6f), r2s = rsqrtf(ss2 * (1.0f / DM) + 1e-6f);
#pragma unroll
        for (int i = 0; i < 4; ++i) { const f32x4 g = *(const f32x4*)(gvec + i * 256 + lane * 4); *(f32x4*)(s1 + i * 256 + lane * 4) = v1[i] * r1 * g; if (has2) *(f32x4*)(s2 + i * 256 + lane * 4) = v2[i] * r2s * g; }
    }
}

constexpr int HG_QS = 0, HG_KS = 17408, HG_KT = 34816, HG_VT = 53248, HG_AS = 71680, HG_ST = 80896, HG_DEC = 115712, HG_TOT = 116224, HG_SSQ = 118272;
__device__ __forceinline__ f32x4 mfma16(bf16x8 a, bf16x8 b, f32x4 c) { return __builtin_amdgcn_mfma_f32_16x16x32_bf16(a, b, c, 0, 0, 0); }

__device__ __forceinline__ void hgrn_unit(const Params& p, int row0, int nc, int h, const float* S0, float* Sout, int mode, float* Dout, LAS unsigned char* lds) {
    unsigned char* big = p.ws + W_BIG;
    bf16_t* zq = (bf16_t*)(big + Z_Q); const bf16_t* zk = (const bf16_t*)(big + Z_K); const bf16_t* zv = (const bf16_t*)(big + Z_V);
    const bf16_t* zog = (const bf16_t*)(big + Z_OG); float* zg = (float*)(big + Z_G);
    bf16_t* ymix = (bf16_t*)(p.ws + W_H);
    LAS bf16_t* Qs = (LAS bf16_t*)(lds + HG_QS); LAS bf16_t* Ks = (LAS bf16_t*)(lds + HG_KS); LAS bf16_t* Kt = (LAS bf16_t*)(lds + HG_KT);
    LAS bf16_t* Vt = (LAS bf16_t*)(lds + HG_VT); LAS bf16_t* As = (LAS bf16_t*)(lds + HG_AS); LAS bf16_t* St = (LAS bf16_t*)(lds + HG_ST);
    LAS float* dec = (LAS float*)(lds + HG_DEC); LAS float* tot = (LAS float*)(lds + HG_TOT); LAS float* ssq = (LAS float*)(lds + HG_SSQ);
    const int tid = threadIdx.x, wid = __builtin_amdgcn_readfirstlane(tid >> 6), lane = tid & 63, fr = lane & 15, fq = lane >> 4;
    const int sg = wid >> 1, kc0 = (wid & 1) << 6, kcol = kc0 + lane;
    const int ttile = wid & 3, half = wid >> 2;
    const int vs = lane, v8 = wid;
    const unsigned lo_e = (unsigned)lane, lo_v = (unsigned)lane * 512u;

    __syncthreads();
    f32x4 Sacc[8];
#pragma unroll
    for (int vt = 0; vt < 8; ++vt) {
        {
            const float* sp = S0 + (size_t)(16 * wid) * 128 + 16 * vt;
            const unsigned so = (unsigned)fq * 512u + fr;
            Sacc[vt] = (f32x4){sp[so], sp[so + 128], sp[so + 256], sp[so + 384]};
        }
        u32x2 w; w.x = cvt_pk_bf16(Sacc[vt][0], Sacc[vt][1]); w.y = cvt_pk_bf16(Sacc[vt][2], Sacc[vt][3]);
        *(LAS u32x2*)(St + (16 * vt + fr) * 136 + 16 * wid + 4 * fq) = w;
    }
    float gg[16]; bf16_t qq[16], kk[16]; u32x4 vv[2];
    {
        const size_t ub = ((size_t)row0 + 16 * sg) * 512 + h * 128 + kc0;
        const float* gp = zg + ub; const bf16_t* qp = zq + ub; const bf16_t* kp = zk + ub;
#pragma unroll
        for (int i = 0; i < 16; ++i) { gg[i] = gp[i * 512 + lo_e]; qq[i] = qp[i * 512 + lo_e]; kk[i] = kp[i * 512 + lo_e]; }
        const bf16_t* vp = zv + (size_t)row0 * 512 + h * 128 + v8 * 8;
#pragma unroll
        for (int i = 0; i < 2; ++i) vv[i] = *(const u32x4*)(vp + i * 64 + lo_v);
    }
    float ecum = 1.0f;
    for (int c = 0; c < nc; ++c) {
        const size_t rowc = (size_t)row0 + (size_t)c * 64;
#pragma unroll
        for (int i = 1; i < 16; ++i) gg[i] += gg[i - 1];
        tot[sg * 128 + kcol] = gg[15];
        __syncthreads();
        {
            const float t0 = tot[kcol], t1 = tot[128 + kcol], t2 = tot[256 + kcol], t3 = tot[384 + kcol];
            const float off = (sg > 0 ? t0 : 0.f) + (sg > 1 ? t1 : 0.f) + (sg > 2 ? t2 : 0.f);
            const float blast = (t0 + t1) + (t2 + t3);
            const float edec = __expf(blast);
            if (sg == 0) dec[kcol] = edec;
            unsigned kt[8];
#pragma unroll
            for (int i = 0; i < 16; i += 2) {
                float kt2[2];
#pragma unroll
                for (int j = 0; j < 2; ++j) {
                    const float bb = off + gg[i + j];
                    const float eb = __expf(bb), einv = __expf(-bb);
                    const float qf = bf2f(qq[i + j]) * eb, kh = bf2f(kk[i + j]) * einv;
                    kt2[j] = kh * edec;
                    const int s = 16 * sg + i + j;
                    Qs[s * 136 + kcol] = (bf16_t)(cvt_pk_bf16(qf, 0.f) & 0xffffu);
                    Ks[s * 136 + kcol] = (bf16_t)(cvt_pk_bf16(kh, 0.f) & 0xffffu);
                    if (mode) (zq + (rowc + 16 * sg) * 512 + h * 128 + kc0)[(i + j) * 512 + lo_e] = (bf16_t)(cvt_pk_bf16(qf * ecum, 0.f) & 0xffffu);
                }
                kt[i >> 1] = cvt_pk_bf16(kt2[0], kt2[1]);
            }
            ecum *= edec;
            *(LAS u32x4*)(Kt + kcol * 72 + 16 * sg) = (u32x4){kt[0], kt[1], kt[2], kt[3]};
            *(LAS u32x4*)(Kt + kcol * 72 + 16 * sg + 8) = (u32x4){kt[4], kt[5], kt[6], kt[7]};
#pragma unroll
            for (int i = 0; i < 2; ++i) {
                const int vb = (v8 + 8 * i) * 8;
#pragma unroll
                for (int j = 0; j < 4; ++j) { const unsigned w = vv[i][j]; Vt[(vb + 2 * j) * 72 + vs] = (bf16_t)(w & 0xffffu); Vt[(vb + 2 * j + 1) * 72 + vs] = (bf16_t)(w >> 16); }
            }
        }
        {
            const size_t rown = (size_t)row0 + (size_t)(c + 1 < nc ? c + 1 : c) * 64;
            const size_t ub = (rown + 16 * sg) * 512 + h * 128 + kc0;
            const float* gp = zg + ub; const bf16_t* qp = zq + ub; const bf16_t* kp = zk + ub;
#pragma unroll
            for (int i = 0; i < 16; ++i) { gg[i] = gp[i * 512 + lo_e]; qq[i] = qp[i * 512 + lo_e]; kk[i] = kp[i * 512 + lo_e]; }
            const bf16_t* vp = zv + rown * 512 + h * 128 + v8 * 8;
#pragma unroll
            for (int i = 0; i < 2; ++i) vv[i] = *(const u32x4*)(vp + i * 64 + lo_v);
        }
        u32x2 og[4];
        const int trow = 16 * ttile + fr;
        {
            const bf16_t* ogp = zog + (rowc + 16 * ttile) * 512 + h * 128 + 64 * half;
            const unsigned lo_o = (unsigned)fr * 512u + 4u * fq;
#pragma unroll
            for (int i = 0; i < 4; ++i) og[i] = *(const u32x2*)(ogp + 16 * i + lo_o);
        }
        __syncthreads();
        bf16x8 Qf[4];
#pragma unroll
        for (int k4 = 0; k4 < 4; ++k4) Qf[k4] = *(const LAS bf16x8*)(Qs + trow * 136 + 32 * k4 + 8 * fq);
#pragma unroll
        for (int si = 0; si < 2; ++si) {
            const int st = 2 * half + si;
            f32x4 a = (f32x4){0.f, 0.f, 0.f, 0.f};
            if (st <= ttile) {
#pragma unroll
                for (int k4 = 0; k4 < 4; ++k4) { const bf16x8 Kf = *(const LAS bf16x8*)(Ks + (16 * st + fr) * 136 + 32 * k4 + 8 * fq); a = mfma16(Kf, Qf[k4], a); }
#pragma unroll
                for (int r = 0; r < 4; ++r) a[r] = (16 * st + 4 * fq + r <= trow) ? a[r] : 0.f;
            }
            u32x2 w; w.x = cvt_pk_bf16(a[0], a[1]); w.y = cvt_pk_bf16(a[2], a[3]);
            *(LAS u32x2*)(As + trow * 72 + 16 * st + 4 * fq) = w;
        }
        __syncthreads();
        f32x4 Oacc[4];
        {
            bf16x8 Af[2];
#pragma unroll
            for (int k2 = 0; k2 < 2; ++k2) Af[k2] = *(const LAS bf16x8*)(As + trow * 72 + 32 * k2 + 8 * fq);
            float sq = 0.f;
#pragma unroll
            for (int i = 0; i < 4; ++i) {
                const int vrow = 16 * (4 * half + i) + fr;
                f32x4 a = (f32x4){0.f, 0.f, 0.f, 0.f};
#pragma unroll
                for (int k2 = 0; k2 < 2; ++k2) { const bf16x8 Vf = *(const LAS bf16x8*)(Vt + vrow * 72 + 32 * k2 + 8 * fq); a = mfma16(Vf, Af[k2], a); }
#pragma unroll
                for (int k4 = 0; k4 < 4; ++k4) { const bf16x8 Sf = *(const LAS bf16x8*)(St + vrow * 136 + 32 * k4 + 8 * fq); a = mfma16(Sf, Qf[k4], a); }
                Oacc[i] = a;
                sq += a[0] * a[0] + a[1] * a[1] + a[2] * a[2] + a[3] * a[3];
            }
            sq += __shfl_xor(sq, 16); sq += __shfl_xor(sq, 32);
            if (fq == 0) ssq[trow * 2 + half] = sq;
            const f32x4 dk = *(const LAS f32x4*)(dec + 16 * wid + 4 * fq);
            bf16x8 Ktf[2];
#pragma unroll
            for (int k2 = 0; k2 < 2; ++k2) Ktf[k2] = *(const LAS bf16x8*)(Kt + (16 * wid + fr) * 72 + 32 * k2 + 8 * fq);
#pragma unroll
            for (int vt = 0; vt < 8; ++vt) {
                f32x4 s = Sacc[vt] * dk;
#pragma unroll
                for (int k2 = 0; k2 < 2; ++k2) { const bf16x8 Vf = *(const LAS bf16x8*)(Vt + (16 * vt + fr) * 72 + 32 * k2 + 8 * fq); s = mfma16(Ktf[k2], Vf, s); }
                Sacc[vt] = s;
            }
        }
        __syncthreads();
#pragma unroll
        for (int vt = 0; vt < 8; ++vt) {
            u32x2 w; w.x = cvt_pk_bf16(Sacc[vt][0], Sacc[vt][1]); w.y = cvt_pk_bf16(Sacc[vt][2], Sacc[vt][3]);
            *(LAS u32x2*)(St + (16 * vt + fr) * 136 + 16 * wid + 4 * fq) = w;
        }
        if (mode == 0) {
            const float tots = ssq[trow * 2] + ssq[trow * 2 + 1];
            const float r = rsqrtf(tots * (1.0f / 128.0f) + 1e-6f);
#pragma unroll
            for (int i = 0; i < 4; ++i) {
                const f32x4 gn = *(const f32x4*)(p.g_hgrn + 16 * (4 * half + i) + 4 * fq);
                const float o0 = Oacc[i][0] * r * gn[0] * bf_lo(og[i].x), o1 = Oacc[i][1] * r * gn[1] * bf_hi(og[i].x);
                const float o2 = Oacc[i][2] * r * gn[2] * bf_lo(og[i].y), o3 = Oacc[i][3] * r * gn[3] * bf_hi(og[i].y);
                u32x2 w; w.x = cvt_pk_bf16(o0, o1); w.y = cvt_pk_bf16(o2, o3);
                *(u32x2*)(ymix + (rowc + 16 * ttile) * DM + h * 128 + 64 * half + 16 * i + ((unsigned)fr * 1024u + 4u * fq)) = w;
            }
        } else {
#pragma unroll
            for (int i = 0; i < 4; ++i) *(f32x4*)(zg + (rowc + 16 * ttile) * 512 + h * 128 + 64 * half + 16 * i + ((unsigned)fr * 512u + 4u * fq)) = Oacc[i];
        }
    }
#pragma unroll
    for (int vt = 0; vt < 8; ++vt)
#pragma unroll
        for (int r = 0; r < 4; ++r) Sout[(size_t)(16 * wid + 4 * fq + r) * 128 + 16 * vt + fr] = Sacc[vt][r];
    if (Dout && sg == 0) Dout[kcol] = ecum;
    __syncthreads();
}

__device__ __forceinline__ void hgrn_fix_unit(const Params& p, int bh, int seg, LAS unsigned char* lds) {
    const unsigned char* big = p.ws + W_BIG;
    const bf16_t* zq = (const bf16_t*)(big + Z_Q); const bf16_t* zog = (const bf16_t*)(big + Z_OG); const float* zg = (const float*)(big + Z_G);
    const float* sseg = (const float*)(p.ws + W_SSEG) + (size_t)bh * 4 * 16384; const float* dseg = (const float*)(p.ws + W_DSEG) + (size_t)bh * 4 * 128;
    bf16_t* ymix = (bf16_t*)(p.ws + W_H);
    LAS bf16_t* St = (LAS bf16_t*)(lds + HG_ST); LAS float* ssq = (LAS float*)(lds + HG_SSQ);
    const int tid = threadIdx.x, wid = __builtin_amdgcn_readfirstlane(tid >> 6), lane = tid & 63, fr = lane & 15, fq = lane >> 4;
    const int ttile = wid & 3, half = wid >> 2, trow = 16 * ttile + fr, h = bh & 3;
    const size_t row0 = (size_t)(bh >> 2) * 4096 + (size_t)seg * 1024;
    __syncthreads();
    {
        f32x4 S[8];
        const unsigned so = (unsigned)fq * 512u + fr;
#pragma unroll
        for (int vt = 0; vt < 8; ++vt) { const float* sp = sseg + (size_t)(16 * wid) * 128 + 16 * vt; S[vt] = (f32x4){sp[so], sp[so + 128], sp[so + 256], sp[so + 384]}; }
        for (int j = 1; j <= seg; ++j) {
            if (j == seg && seg != 3) break;
            const f32x4 d = *(const f32x4*)(dseg + j * 128 + 16 * wid + 4 * fq);
            if (j == seg) {
                float* so_ = p.out + O_STP + (size_t)bh * 16384;
#pragma unroll
                for (int vt = 0; vt < 8; ++vt) { const float* sp = sseg + (size_t)j * 16384 + (size_t)(16 * wid) * 128 + 16 * vt; float* op = so_ + (size_t)(16 * wid) * 128 + 16 * vt;
                    op[so] = d[0] * S[vt][0] + sp[so]; op[so + 128] = d[1] * S[vt][1] + sp[so + 128]; op[so + 256] = d[2] * S[vt][2] + sp[so + 256]; op[so + 384] = d[3] * S[vt][3] + sp[so + 384]; }
            } else {
#pragma unroll
                for (int vt = 0; vt < 8; ++vt) { const float* sp = sseg + (size_t)j * 16384 + (size_t)(16 * wid) * 128 + 16 * vt;
                    S[vt] = (f32x4){d[0] * S[vt][0] + sp[so], d[1] * S[vt][1] + sp[so + 128], d[2] * S[vt][2] + sp[so + 256], d[3] * S[vt][3] + sp[so + 384]}; }
            }
        }
#pragma unroll
        for (int vt = 0; vt < 8; ++vt) { u32x2 w; w.x = cvt_pk_bf16(S[vt][0], S[vt][1]); w.y = cvt_pk_bf16(S[vt][2], S[vt][3]); *(LAS u32x2*)(St + (16 * vt + fr) * 136 + 16 * wid + 4 * fq) = w; }
    }
    __syncthreads();
    bf16x8 Sf[4][4];
#pragma unroll
    for (int i = 0; i < 4; ++i)
#pragma unroll
        for (int k4 = 0; k4 < 4; ++k4) Sf[i][k4] = *(const LAS bf16x8*)(St + (16 * (4 * half + i) + fr) * 136 + 32 * k4 + 8 * fq);
    f32x4 gn[4];
#pragma unroll
    for (int i = 0; i < 4; ++i) gn[i] = *(const f32x4*)(p.g_hgrn + 16 * (4 * half + i) + 4 * fq);
    const unsigned lo_q = (unsigned)fr * 512u + 8u * fq, lo_o = (unsigned)fr * 512u + 4u * fq;
    for (int c = 0; c < 16; ++c) {
        const size_t rowt = row0 + (size_t)c * 64 + 16 * ttile;
        bf16x8 Qf[4]; f32x4 acc[4]; u32x2 og[4];
#pragma unroll
        for (int k4 = 0; k4 < 4; ++k4) Qf[k4] = *(const bf16x8*)(zq + rowt * 512 + h * 128 + 32 * k4 + lo_q);
#pragma unroll
        for (int i = 0; i < 4; ++i) { acc[i] = *(const f32x4*)(zg + rowt * 512 + h * 128 + 64 * half + 16 * i + lo_o); og[i] = *(const u32x2*)(zog + rowt * 512 + h * 128 + 64 * half + 16 * i + lo_o); }
        float sq = 0.f;
#pragma unroll
        for (int i = 0; i < 4; ++i) {
#pragma unroll
            for (int k4 = 0; k4 < 4; ++k4) acc[i] = mfma16(Sf[i][k4], Qf[k4], acc[i]);
            sq += acc[i][0] * acc[i][0] + acc[i][1] * acc[i][1] + acc[i][2] * acc[i][2] + acc[i][3] * acc[i][3];
        }
        sq += __shfl_xor(sq, 16); sq += __shfl_xor(sq, 32);
        LAS float* sp = ssq + (c & 1) * 128;
        if (fq == 0) sp[trow * 2 + half] = sq;
        __syncthreads();
        const float r = rsqrtf((sp[trow * 2] + sp[trow * 2 + 1]) * (1.0f / 128.0f) + 1e-6f);
#pragma unroll
        for (int i = 0; i < 4; ++i) {
            const float o0 = acc[i][0] * r * gn[i][0] * bf_lo(og[i].x), o1 = acc[i][1] * r * gn[i][1] * bf_hi(og[i].x);
            const float o2 = acc[i][2] * r * gn[i][2] * bf_lo(og[i].y), o3 = acc[i][3] * r * gn[i][3] * bf_hi(og[i].y);
            u32x2 w; w.x = cvt_pk_bf16(o0, o1); w.y = cvt_pk_bf16(o2, o3);
            *(u32x2*)(ymix + rowt * DM + h * 128 + 64 * half + 16 * i + ((unsigned)fr * 1024u + 4u * fq)) = w;
        }
    }
    __syncthreads();
}

constexpr int AT_KS = 0, AT_VT = 27648;
__device__ __forceinline__ void attn_unit(const Params& p, int a, LAS unsigned char* lds) {
    const unsigned char* big = p.ws + W_BIG;
    const bf16_t* zsq = (const bf16_t*)(big + Z_SQ); const bf16_t* zsk = (const bf16_t*)(big + Z_SK); const bf16_t* zsv = (const bf16_t*)(big + Z_SV);
    bf16_t* ymix = (bf16_t*)(p.ws + W_H);
    LAS bf16_t* Ks = (LAS bf16_t*)(lds + AT_KS); LAS bf16_t* Vt = (LAS bf16_t*)(lds + AT_VT);
    const int tid = threadIdx.x, wid = tid >> 6, lane = tid & 63, fr = lane & 15, fq = lane >> 4;
    int kvh, jb0; size_t row0; bool sample; int sb = 0, bb = 0, cc = 0;
    if (a < 2048) { bb = a >> 7; cc = (a >> 1) & 63; kvh = a & 1; row0 = (size_t)bb * 4096 + (size_t)cc * 64; jb0 = cc >= 2 ? 0 : 2 - cc; sample = false; }
    else { const int s2 = a - 2048; sb = s2 >> 1; kvh = s2 & 1; row0 = (size_t)TP + (size_t)sb * 64; jb0 = 0; sample = true; }
    __syncthreads();
    for (int jb = jb0; jb < 3; ++jb) {
        const int ks = tid >> 3, kd8 = tid & 7;
        const int vsx = tid & 63, vd8 = tid >> 6;
        u32x4 kw, vw;
        if (sample && jb < 2) {
            const float* kp = p.cache_k + ((size_t)(sb * 128 + jb * 64 + ks) * 2 + kvh) * 64 + kd8 * 8;
            const float* vp = p.cache_v + ((size_t)(sb * 128 + jb * 64 + vsx) * 2 + kvh) * 64 + vd8 * 8;
            const f32x4 k0 = *(const f32x4*)kp, k1 = *(const f32x4*)(kp + 4), v0 = *(const f32x4*)vp, v1 = *(const f32x4*)(vp + 4);
            kw = (u32x4){cvt_pk_bf16(k0[0], k0[1]), cvt_pk_bf16(k0[2], k0[3]), cvt_pk_bf16(k1[0], k1[1]), cvt_pk_bf16(k1[2], k1[3])};
            vw = (u32x4){cvt_pk_bf16(v0[0], v0[1]), cvt_pk_bf16(v0[2], v0[3]), cvt_pk_bf16(v1[0], v1[1]), cvt_pk_bf16(v1[2], v1[3])};
        } else {
            const size_t kr = sample ? row0 : row0 - 128 + (size_t)jb * 64;
            kw = *(const u32x4*)(zsk + (kr + ks) * 128 + kvh * 64 + kd8 * 8);
            vw = *(const u32x4*)(zsv + (kr + vsx) * 128 + kvh * 64 + vd8 * 8);
        }
        *(LAS u32x4*)(Ks + (jb * 64 + ks) * 72 + kd8 * 8) = kw;
#pragma unroll
        for (int j = 0; j < 4; ++j) { const unsigned w = vw[j]; Vt[(vd8 * 8 + 2 * j) * 200 + jb * 64 + vsx] = (bf16_t)(w & 0xffffu); Vt[(vd8 * 8 + 2 * j + 1) * 200 + jb * 64 + vsx] = (bf16_t)(w >> 16); }
    }
    __syncthreads();
#pragma unroll 1
    for (int task = wid; task < 16; task += 8) {
        const int gi = task >> 2, tt = task & 3, hh = kvh * 4 + gi;
        const int t = 16 * tt + fr;
        const float slope = exp2f(-(float)(hh + 1)), sink = p.sinks[hh];
        bf16x8 Qf[2];
#pragma unroll
        for (int kd = 0; kd < 2; ++kd) Qf[kd] = *(const bf16x8*)(zsq + (row0 + t) * 512 + hh * 64 + 32 * kd + 8 * fq);
        f32x4 sc[12];
        float mx = sink;
#pragma unroll
        for (int tile = 0; tile < 12; ++tile) {
            if (tile >= 4 * jb0) {
                f32x4 acc = (f32x4){0.f, 0.f, 0.f, 0.f};
#pragma unroll
                for (int kd = 0; kd < 2; ++kd) { const bf16x8 Kf = *(const LAS bf16x8*)(Ks + (16 * tile + fr) * 72 + 32 * kd + 8 * fq); acc = mfma16(Kf, Qf[kd], acc); }
#pragma unroll
                for (int r = 0; r < 4; ++r) {
                    const int s = 16 * tile + 4 * fq + r;
                    const float d = fabsf((float)(t + 128 - s));
                    acc[r] = acc[r] * 0.125f - slope * d;
                    mx = fmaxf(mx, acc[r]);
                }
                sc[tile] = acc;
            } else sc[tile] = (f32x4){-INFINITY, -INFINITY, -INFINITY, -INFINITY};
        }
        mx = fmaxf(mx, __shfl_xor(mx, 16)); mx = fmaxf(mx, __shfl_xor(mx, 32));
        float l = 0.f;
#pragma unroll
        for (int tile = 0; tile < 12; ++tile)
#pragma unroll
            for (int r = 0; r < 4; ++r) { const float e = __expf(sc[tile][r] - mx); sc[tile][r] = e; l += e; }
        l += __shfl_xor(l, 16); l += __shfl_xor(l, 32);
        l += __expf(sink - mx);
        const float rl = 1.0f / l;
        f32x4 o[4];
#pragma unroll
        for (int dt = 0; dt < 4; ++dt) o[dt] = (f32x4){0.f, 0.f, 0.f, 0.f};
#pragma unroll
        for (int k6 = 0; k6 < 6; ++k6) {
            if (k6 >= 2 * jb0) {
                union { u32x4 u; bf16x8 b; } pf;
                pf.u = (u32x4){cvt_pk_bf16(sc[2 * k6][0], sc[2 * k6][1]), cvt_pk_bf16(sc[2 * k6][2], sc[2 * k6][3]), cvt_pk_bf16(sc[2 * k6 + 1][0], sc[2 * k6 + 1][1]), cvt_pk_bf16(sc[2 * k6 + 1][2], sc[2 * k6 + 1][3])};
#pragma unroll
                for (int dt = 0; dt < 4; ++dt) {
                    union { u32x4 u; bf16x8 b; } vf;
                    const u32x2 lo = *(const LAS u32x2*)(Vt + (16 * dt + fr) * 200 + 32 * k6 + 4 * fq), hi = *(const LAS u32x2*)(Vt + (16 * dt + fr) * 200 + 32 * k6 + 16 + 4 * fq);
                    vf.u = (u32x4){lo.x, lo.y, hi.x, hi.y};
                    o[dt] = mfma16(vf.b, pf.b, o[dt]);
                }
            }
        }
#pragma unroll
        for (int dt = 0; dt < 4; ++dt) {
            u32x2 w; w.x = cvt_pk_bf16(o[dt][0] * rl, o[dt][1] * rl); w.y = cvt_pk_bf16(o[dt][2] * rl, o[dt][3] * rl);
            *(u32x2*)(ymix + (row0 + t) * DM + 512 + hh * 64 + 16 * dt + 4 * fq) = w;
        }
    }
}

__device__ __forceinline__ void mixer_phase_a(const Params& p, LAS unsigned char* lds) {
    for (int u = blockIdx.x; u < 256; u += gridDim.x) {
        const int bh = u >> 2, seg = u & 3, b = bh >> 2, h = bh & 3;
        hgrn_unit(p, b * 4096 + seg * 1024, 16, h, (const float*)(p.ws + W_ZERO), (float*)(p.ws + W_SSEG) + (size_t)u * 16384, seg ? 1 : 0,
                  (float*)(p.ws + W_DSEG) + (size_t)u * 128, lds);
    }
}
__device__ __forceinline__ void mixer_phase_b(const Params& p, LAS unsigned char* lds) {
    for (int it = blockIdx.x; it < 192 + 2112 + 128; it += gridDim.x) {
        if (it < 192) hgrn_fix_unit(p, it / 3, 1 + it % 3, lds);
        else if (it < 192 + 2112) attn_unit(p, it - 192, lds);
        else { const int su = it - 192 - 2112, sb = su >> 2, h = su & 3; hgrn_unit(p, TP + sb * 64, 1, h, p.state + (size_t)su * 16384, p.out + O_STS + (size_t)su * 16384, 0, nullptr, lds); }
    }
}

__global__ void __launch_bounds__(512, 2) mk_fwd(Params p) {
    extern __shared__ __attribute__((aligned(16))) unsigned char lds_raw[];
    LAS unsigned char* lds = (LAS unsigned char*)lds_raw;
    cg::grid_group grid = cg::this_grid();
    float* mod = (float*)(p.ws + W_MOD);
    bf16_t* hbuf = (bf16_t*)(p.ws + W_H);
    bf16_t* hidden = (bf16_t*)(p.ws + W_BIG);
    float* xres = p.out + O_Y;
    pg8::StaticOrder so;
#ifndef PH_MASK
#define PH_MASK 0x1FFF
#endif
#define PHASE_BEGIN(i) if (((PH_MASK >> (i)) & 1) && p.ph_lo <= (i) && (i) < p.ph_hi) { if ((i) > p.ph_lo) grid.sync();
#define PHASE_END }
    PHASE_BEGIN(0) phase0(p, lds); PHASE_END
    PHASE_BEGIN(1) norm_mod_phase(p.x_p, p.x_s, p.g_ffn1, mod, 0, 1, hbuf); PHASE_END
    PHASE_BEGIN(2) { so.init(T, 2 * DFF, gridDim.x, blockIdx.x); pg8::Gemm g{hbuf, (const bf16_t*)(p.ws + W_UP1), T, 2 * DFF, DM}; EpiSwiglu e{hidden}; pg8::gemm_phase(lds, g, so, e); } PHASE_END
    PHASE_BEGIN(3) { so.init(T, DM, gridDim.x, blockIdx.x); pg8::Gemm g{hidden, (const bf16_t*)(p.ws + W_DN1), T, DM, DFF}; EpiResid e{p.x_p, p.x_s, xres, mod + 2 * DM, 0.5f}; pg8::gemm_phase(lds, g, so, e); } PHASE_END
    PHASE_BEGIN(4) norm_mod_phase(xres, xres + (size_t)TP * DM, p.g_mix, mod, 3, 4, hbuf); PHASE_END
    PHASE_BEGIN(5) { so.init(T, DIN, gridDim.x, blockIdx.x); pg8::Gemm g{hbuf, (const bf16_t*)(p.ws + W_IN), T, DIN, DM}; EpiInproj e{p.ws + W_BIG, p.lb_logits, p.out}; pg8::gemm_phase(lds, g, so, e); } PHASE_END
    PHASE_BEGIN(6) mixer_phase_a(p, lds); PHASE_END
    PHASE_BEGIN(7) mixer_phase_b(p, lds); PHASE_END
    PHASE_BEGIN(8) { so.init(T, DM, gridDim.x, blockIdx.x); pg8::Gemm g{hbuf, (const bf16_t*)(p.ws + W_OUT), T, DM, DM}; EpiResid e{xres, xres + (size_t)TP * DM, xres, mod + 5 * DM, 1.0f}; pg8::gemm_phase(lds, g, so, e); } PHASE_END
    PHASE_BEGIN(9) norm_mod_phase(xres, xres + (size_t)TP * DM, p.g_ffn2, mod, 6, 7, hbuf); PHASE_END
    PHASE_BEGIN(10) { so.init(T, 2 * DFF, gridDim.x, blockIdx.x); pg8::Gemm g{hbuf, (const bf16_t*)(p.ws + W_UP2), T, 2 * DFF, DM}; EpiSwiglu e{hidden}; pg8::gemm_phase(lds, g, so, e); } PHASE_END
    PHASE_BEGIN(11) { so.init(T, DM, gridDim.x, blockIdx.x); pg8::Gemm g{hidden, (const bf16_t*)(p.ws + W_DN2), T, DM, DFF}; EpiResid e{xres, xres + (size_t)TP * DM, xres, mod + 8 * DM, 0.5f}; pg8::gemm_phase(lds, g, so, e); } PHASE_END
    PHASE_BEGIN(12) final_norm_phase(xres, p.g_final); PHASE_END
}

extern "C" void kernel_launch(void* const* d_in, const int* in_sizes, int n_in, void* d_out, int out_size, void* d_ws, size_t ws_size, hipStream_t stream) {
    static int grid_blocks = 0;
    if (!grid_blocks) {
        int dev = 0, cus = 0, per_cu = 0;
        hipGetDevice(&dev);
        hipDeviceGetAttribute(&cus, hipDeviceAttributeMultiprocessorCount, dev);
        hipFuncSetAttribute((const void*)mk_fwd, hipFuncAttributeMaxDynamicSharedMemorySize, LDS_BYTES);
        hipOccupancyMaxActiveBlocksPerMultiprocessor(&per_cu, (const void*)mk_fwd, 512, LDS_BYTES);
        if (per_cu < 1) per_cu = 1;
        grid_blocks = cus * per_cu;
        if (grid_blocks > 256) grid_blocks = 256;
        if (ws_size < WS_NEED) fprintf(stderr, "kernel_launch: workspace too small: %zu < %zu\n", ws_size, (size_t)WS_NEED);
    }
    Params p{};
    const float** pp = (const float**)&p;
    for (int i = 0; i < 22; ++i) pp[i] = (const float*)d_in[i];
    p.out = (float*)d_out; p.ws = (unsigned char*)d_ws;
#if MK_LAUNCHES == 1
    p.ph_lo = 0; p.ph_hi = NPHASE;
    void* args[] = {&p};
    hipError_t e = hipLaunchCooperativeKernel((const void*)mk_fwd, dim3(grid_blocks), dim3(512), args, LDS_BYTES, stream);
    if (e != hipSuccess) fprintf(stderr, "cooperative launch failed: %s (grid %d)\n", hipGetErrorString(e), grid_blocks);
#else
    for (int i = 0; i < NPHASE; ++i) { p.ph_lo = i; p.ph_hi = i + 1; hipLaunchKernelGGL(mk_fwd, dim3(grid_blocks), dim3(512), LDS_BYTES, stream, p); }
#endif
}
```

```cpp
#include <hip/hip_runtime.h>
#include <hip/hip_cooperative_groups.h>
#include <cstdio>
namespace cg = cooperative_groups;

#ifndef MK_LAUNCHES
#define MK_LAUNCHES 1
#endif

#define LAS __attribute__((address_space(3)))
typedef unsigned short bf16_t;
typedef short bf16x8 __attribute__((ext_vector_type(8)));
typedef float f32x4 __attribute__((ext_vector_type(4)));
typedef unsigned u32x4 __attribute__((ext_vector_type(4)));
typedef unsigned u32x2 __attribute__((ext_vector_type(2)));

constexpr int TP = 65536, TS = 2048, T = TP + TS, DM = 1024, DFF = 2816, DIN = 2816, NB = 48, NMOD = 9216;
constexpr int LDS_BYTES = 131072 + 8192;
constexpr int NPHASE = 11;

constexpr size_t O_Y = 0, O_STP = (size_t)T * DM, O_CKP = O_STP + 16 * 4 * 16384, O_CVP = O_CKP + 16 * 16384, O_STS = O_CVP + 16 * 16384,
                 O_CKS = O_STS + 32 * 4 * 16384, O_CVS = O_CKS + 32 * 16384;
constexpr size_t W_UP1 = 0, W_DN1 = W_UP1 + (size_t)2 * DFF * DM * 2, W_IN = W_DN1 + (size_t)DM * DFF * 2, W_OUT = W_IN + (size_t)DIN * DM * 2,
                 W_UP2 = W_OUT + (size_t)DM * DM * 2, W_DN2 = W_UP2 + (size_t)2 * DFF * DM * 2, W_MOD = W_DN2 + (size_t)DM * DFF * 2,
                 W_ZERO = W_MOD + (size_t)NB * NMOD * 4, W_H = W_ZERO + 65536, W_BIG = W_H + (size_t)T * DM * 2;
constexpr size_t Z_Q = 0, Z_K = Z_Q + (size_t)T * 512 * 2, Z_V = Z_K + (size_t)T * 512 * 2, Z_OG = Z_V + (size_t)T * 512 * 2, Z_SQ = Z_OG + (size_t)T * 512 * 2,
                 Z_G = Z_SQ + (size_t)T * 512 * 2, Z_SK = Z_G + (size_t)T * 512 * 4, Z_SV = Z_SK + (size_t)T * 128 * 2, Z_END = Z_SV + (size_t)T * 128 * 2;
constexpr size_t W_SSEG = W_BIG + Z_END, W_DSEG = W_SSEG + (size_t)64 * 4 * 16384 * 4, W_HB2 = W_DSEG + (size_t)64 * 4 * 128 * 4, W_SSQ = W_HB2 + (size_t)T * DM * 2  , W_SHWI = W_SSQ + (size_t)2 * T * 4  ,
                 W_SHWU = W_SHWI + (size_t)256 * DIN * 4  , W_ASH = W_SHWU + (size_t)256 * 2 * DFF * 4  , WS_NEED = W_ASH + (size_t)2 * 256 * DM * 2;

struct Params {
    const float *x_p, *x_s, *state, *cache_k, *cache_v, *c_p, *c_s, *w_ada, *b_ada, *g_ffn1, *w_up1, *w_down1, *g_mix, *w_in, *lb_logits, *g_hgrn, *sinks, *w_out,
        *g_ffn2, *w_up2, *w_down2, *g_final;
    float* out;
    unsigned char* ws;
    int ph_lo, ph_hi;
};

typedef float f32x2 __attribute__((ext_vector_type(2)));
typedef __bf16 bf16x2_t __attribute__((ext_vector_type(2)));
__device__ __forceinline__ unsigned cvt_pk_bf16(float lo, float hi) { const f32x2 v = {lo, hi}; return __builtin_bit_cast(unsigned, __builtin_convertvector(v, bf16x2_t)); }
__device__ __forceinline__ float bf_lo(unsigned w) { return __uint_as_float(w << 16); }
__device__ __forceinline__ float bf_hi(unsigned w) { return __uint_as_float(w & 0xffff0000u); }
__device__ __forceinline__ float bf2f(bf16_t b) { return __uint_as_float(((unsigned)b) << 16); }
__device__ __forceinline__ float fsilu(float v) { return v * __builtin_amdgcn_rcpf(1.0f + __expf(-v)); }
__device__ __forceinline__ int batch_of_row(int row) { return row < TP ? (row >> 12) : 16 + ((row - TP) >> 6); }

namespace pg8 {
constexpr int BM = 256, BK = 64, HALF = 128, HTB = HALF * BK * 2, STAGE_BYTES = 8 * HTB, NXCD = 8, WGM = 8;
__device__ __forceinline__ int lds_byte(int r, int c) { const int st = (r >> 4) * 2 + (c >> 5), rr = r & 15, cc = c & 31, ob = rr * 64 + cc * 2; return st * 1024 + (ob ^ (((ob >> 9) & 1) << 5)); }
__device__ __forceinline__ void stage_rc(int b, int& R, int& C) { const int st = b / 1024, sb = b % 1024, swz = sb ^ (((sb >> 9) & 1) << 5); R = (st >> 1) * 16 + swz / 64; C = (st & 1) * 32 + (swz % 64) / 2; }
__device__ __forceinline__ int perm32(int rho) { const int n = rho >> 4, i = rho & 15; return 8 * (i >> 2) + 4 * n + (i & 3); }
struct Unit { int pm, pn; };
struct Gemm { const bf16_t* A; const bf16_t* Bt; int M, N, K; };
struct StaticOrder {
    int nM, nN, nwg, G, c;
    __device__ void init(int M, int N, int G_, int c_) { nM = M / BM; nN = N / BM; nwg = nM * nN; G = G_; c = c_; }
    __device__ bool next(int i, Unit& u) const {
        const long L = (long)i * G + c; if (L >= nwg) return false;
        int wgid = (int)L; { const int q = nwg / NXCD, r = nwg % NXCD, xcd = wgid % NXCD, off = wgid / NXCD; wgid = (xcd < r ? xcd * (q + 1) : r * (q + 1) + (xcd - r) * q) + off; }
        const int nig = WGM * nN, gid = wgid / nig, fm = gid * WGM, gsz = (nM - fm) < WGM ? (nM - fm) : WGM;
        u.pm = fm + ((wgid % nig) % gsz); u.pn = (wgid % nig) / gsz; return true;
    }
};

template <class Epi>
__device__ __forceinline__ void gemm_phase(LAS unsigned char* lds, const Gemm g, const StaticOrder& S, const Epi& E) {
    const int tid = threadIdx.x, wid = __builtin_amdgcn_readfirstlane(tid >> 6), lane = tid & 63, wr = wid >> 2, wc = wid & 3, fr = lane & 15, fq = lane >> 4;
    const int K = g.K, nt = K / BK;
    unsigned voffA[2], voffB[2];
#pragma unroll
    for (int i = 0; i < 2; ++i) { int R, C; stage_rc(tid * 16 + i * 8192, R, C); const int Rb = Epi::PERM ? ((R & ~31) + perm32(R & 31)) : R;
        voffA[i] = (unsigned)(R * K + C) * 2u; voffB[i] = (unsigned)(Rb * K + C) * 2u; }
    const size_t kstep = (size_t)(BK * 2);
    const size_t hstep = (size_t)HALF * K * 2;
    const size_t tstep = 2 * hstep;
    const unsigned ldsw = (unsigned)wid * 1024u;
    const int aoff = lds_byte(wr * 64 + fr, fq * 8), boff = lds_byte(wc * 32 + fr, fq * 8);
#define PG8_SA(b, h) (((b) * 2 + (h)) * HTB)
#define PG8_SB(b, h) ((4 + (b) * 2 + (h)) * HTB)
#define PG8_STAGE(bufoff, gbase, voff) do { _Pragma("unroll") for (int _i = 0; _i < 2; ++_i) \
        __builtin_amdgcn_global_load_lds((const unsigned*)((const char*)(gbase) + (voff)[_i]), (LAS unsigned*)(lds + (bufoff) + ldsw + _i * 8192), 16, 0, 0); } while (0)
#define PG8_LDA(dst, b, h) do { _Pragma("unroll") for (int m = 0; m < 4; ++m) _Pragma("unroll") for (int k = 0; k < 2; ++k) dst[m][k] = *(const LAS bf16x8*)(lds + PG8_SA(b, h) + aoff + m * 2048 + k * 1024); } while (0)
#define PG8_LDB(dst, b, h) do { _Pragma("unroll") for (int n = 0; n < 2; ++n) _Pragma("unroll") for (int k = 0; k < 2; ++k) dst[n][k] = *(const LAS bf16x8*)(lds + PG8_SB(b, h) + boff + n * 2048 + k * 1024); } while (0)
#define PG8_MMA(ai, bj, At, Bt) do { __builtin_amdgcn_s_setprio(1); _Pragma("unroll") for (int m = 0; m < 4; ++m) _Pragma("unroll") for (int n = 0; n < 2; ++n) _Pragma("unroll") for (int k = 0; k < 2; ++k) \
        acc[ai][bj][m][n] = __builtin_amdgcn_mfma_f32_16x16x32_bf16(Bt[n][k], At[m][k], acc[ai][bj][m][n], 0, 0, 0); __builtin_amdgcn_s_setprio(0); } while (0)
#define PG8_WAIT_V(n) asm volatile("s_waitcnt vmcnt(" #n ")" ::: "memory")
#define PG8_WAIT_L(n) asm volatile("s_waitcnt lgkmcnt(" #n ")" ::: "memory")
#define PG8_BAR __builtin_amdgcn_s_barrier()
#define PG8_SCHED __builtin_amdgcn_sched_barrier(0)
    Unit cur, nxt; int ui = 0;
    if (!S.next(0, cur)) return;
    f32x4 acc[2][2][4][2];
#pragma unroll
    for (int a = 0; a < 2; ++a)
#pragma unroll
        for (int b = 0; b < 2; ++b)
#pragma unroll
            for (int m = 0; m < 4; ++m)
#pragma unroll
                for (int n = 0; n < 2; ++n) acc[a][b][m][n] = (f32x4){0.f, 0.f, 0.f, 0.f};
    bf16x8 At[4][2], B0[2][2], B1[2][2];
    const char* cA = (const char*)g.A + (size_t)cur.pm * tstep; const char* cB = (const char*)g.Bt + (size_t)cur.pn * tstep;
    PG8_STAGE(PG8_SB(0, 0), cB, voffB); PG8_STAGE(PG8_SA(0, 0), cA, voffA); PG8_STAGE(PG8_SB(0, 1), cB + hstep, voffB); PG8_STAGE(PG8_SA(0, 1), cA + hstep, voffA);
    if (wr == 1) PG8_BAR;
    PG8_WAIT_V(4); PG8_BAR;
    PG8_STAGE(PG8_SB(1, 0), cB + kstep, voffB); PG8_STAGE(PG8_SA(1, 0), cA + kstep, voffA); PG8_STAGE(PG8_SB(1, 1), cB + hstep + kstep, voffB);
    PG8_WAIT_V(6); PG8_BAR;
    for (;;) {
        const bool has_next = S.next(ui + 1, nxt);
        const char* nA = has_next ? (const char*)g.A + (size_t)nxt.pm * tstep : cA; const char* nB = has_next ? (const char*)g.Bt + (size_t)nxt.pn * tstep : cB;
        for (int t = 0; t < nt; t += 2) {
            const bool last = (t == nt - 2);
            const char* a1 = cA + (size_t)(t + 1) * kstep;
            const char* a2 = last ? nA : cA + (size_t)(t + 2) * kstep; const char* b2 = last ? nB : cB + (size_t)(t + 2) * kstep;
            const char* a3 = a2 + kstep; const char* b3 = b2 + kstep;
            PG8_LDB(B0, 0, 0); PG8_SCHED; PG8_LDA(At, 0, 0); PG8_STAGE(PG8_SA(1, 1), a1 + hstep, voffA);
            PG8_WAIT_L(8); PG8_BAR; PG8_WAIT_L(0); PG8_MMA(0, 0, At, B0); PG8_BAR; PG8_SCHED;
            PG8_LDB(B1, 0, 1); PG8_STAGE(PG8_SB(0, 0), b2, voffB);
            PG8_BAR; PG8_WAIT_L(0); PG8_MMA(0, 1, At, B1); PG8_BAR;
            PG8_LDA(At, 0, 1); PG8_STAGE(PG8_SA(0, 0), a2, voffA);
            PG8_BAR; PG8_WAIT_L(0); PG8_MMA(1, 0, At, B0); PG8_BAR; PG8_SCHED;
            PG8_STAGE(PG8_SB(0, 1), b2 + hstep, voffB);
            PG8_WAIT_V(6); PG8_BAR; PG8_MMA(1, 1, At, B1); PG8_BAR;
            PG8_LDB(B0, 1, 0); PG8_SCHED; PG8_LDA(At, 1, 0); PG8_STAGE(PG8_SA(0, 1), a2 + hstep, voffA);
            PG8_WAIT_L(8); PG8_BAR; PG8_WAIT_L(0); PG8_MMA(0, 0, At, B0); PG8_BAR; PG8_SCHED;
            PG8_LDB(B1, 1, 1); PG8_STAGE(PG8_SB(1, 0), b3, voffB);
            PG8_BAR; PG8_WAIT_L(0); PG8_MMA(0, 1, At, B1); PG8_BAR;
            PG8_LDA(At, 1, 1); PG8_STAGE(PG8_SA(1, 0), a3, voffA);
            PG8_BAR; PG8_WAIT_L(0); PG8_MMA(1, 0, At, B0); PG8_BAR; PG8_SCHED;
            PG8_STAGE(PG8_SB(1, 1), b3 + hstep, voffB);
            PG8_WAIT_V(6); PG8_BAR; PG8_MMA(1, 1, At, B1); PG8_BAR;
        }
        E(acc, cur, wr, wc, fr, fq);
        if (!has_next) break;
#pragma unroll
        for (int a = 0; a < 2; ++a)
#pragma unroll
            for (int b = 0; b < 2; ++b)
#pragma unroll
                for (int m = 0; m < 4; ++m)
#pragma unroll
                    for (int n = 0; n < 2; ++n) acc[a][b][m][n] = (f32x4){0.f, 0.f, 0.f, 0.f};
        cur = nxt; cA = nA; cB = nB; ++ui;
    }
    PG8_WAIT_V(0);
    if (wr == 0) PG8_BAR;
    PG8_BAR;
#undef PG8_SA
#undef PG8_SB
#undef PG8_STAGE
#undef PG8_LDA
#undef PG8_LDB
#undef PG8_MMA
#undef PG8_WAIT_V
#undef PG8_WAIT_L
#undef PG8_BAR
#undef PG8_SCHED
}
}
using pg8::Unit;

struct EpiSwiglu {
    static constexpr bool PERM = true;
    bf16_t* H; const float* ssq; const float* shw;
    __device__ __forceinline__ void operator()(const f32x4 (&acc)[2][2][4][2], const Unit& u, int wr, int wc, int fr, int fq) const {
        const int row0 = u.pm * 256 + wr * 64 + fr, col0 = u.pn * 128 + wc * 32 + 8 * fq;
#pragma unroll
        for (int ai = 0; ai < 2; ++ai) {
            f32x4 sg[2], su[2];
            if (ssq) {
                const int b = u.pm < 256 ? (u.pm >> 4) : 16 + (u.pm - 256) * 4 + ai * 2 + wr;
                const float* sp = shw + (size_t)b * (2 * DFF) + u.pn * 256 + wc * 32 + 8 * fq;
                sg[0] = *(const f32x4*)sp; sg[1] = *(const f32x4*)(sp + 4); su[0] = *(const f32x4*)(sp + 128); su[1] = *(const f32x4*)(sp + 132);
            }
#pragma unroll
            for (int m = 0; m < 4; ++m) {
                const int row = row0 + ai * 128 + m * 16;
                bf16_t* rowp = H + (size_t)row * DFF + col0;
                const float r = ssq ? rsqrtf(ssq[row] * (1.0f / DM) + 1e-6f) : 1.0f;
                float v[8];
#pragma unroll
                for (int n = 0; n < 2; ++n)
#pragma unroll
                    for (int j = 0; j < 4; ++j) {
                        float g = acc[ai][0][m][n][j], uu = acc[ai][1][m][n][j];
                        if (ssq) { g = g * r + sg[n][j]; uu = uu * r + su[n][j]; }
                        v[n * 4 + j] = fsilu(g) * uu;
                    }
                u32x4 w; w.x = cvt_pk_bf16(v[0], v[1]); w.y = cvt_pk_bf16(v[2], v[3]); w.z = cvt_pk_bf16(v[4], v[5]); w.w = cvt_pk_bf16(v[6], v[7]);
                *(u32x4*)rowp = w;
            }
        }
    }
};
struct EpiPlainF32 {
    static constexpr bool PERM = false;
    float* C; int ldc;
    __device__ __forceinline__ void operator()(const f32x4 (&acc)[2][2][4][2], const Unit& u, int wr, int wc, int fr, int fq) const {
        const int col0 = u.pn * 256 + wc * 32 + 4 * fq;
#pragma unroll
        for (int ai = 0; ai < 2; ++ai)
#pragma unroll
            for (int m = 0; m < 4; ++m) {
                float* op = C + (size_t)(u.pm * 256 + ai * 128 + wr * 64 + m * 16 + fr) * ldc + col0;
#pragma unroll
                for (int bj = 0; bj < 2; ++bj)
#pragma unroll
                    for (int n = 0; n < 2; ++n) *(f32x4*)(op + bj * 128 + n * 16) = acc[ai][bj][m][n];
            }
    }
};
struct EpiResid {
    static constexpr bool PERM = false;
    const float* xa; const float* xb; float* out; const float* gate;
    bf16_t* an; const float* gn; const float* scn; float* ssq;
    float coef; int pad_;
    __device__ __forceinline__ void operator()(const f32x4 (&acc)[2][2][4][2], const Unit& u, int wr, int wc, int fr, int fq) const {
        const int col0 = u.pn * 256 + wc * 32 + 4 * fq;
        const float* const xa = this->xa; const float* const xb = this->xb; float* const out = this->out; const float* const gate = this->gate; const float coef = this->coef;
        bf16_t* const an = this->an; const float* const gn = this->gn; const float* const scn = this->scn; float* const ssq = this->ssq;
#pragma unroll
        for (int ai = 0; ai < 2; ++ai) {
            const int b = u.pm < 256 ? (u.pm >> 4) : 16 + (u.pm - 256) * 4 + ai * 2 + wr;
            const float* gp = gate + (size_t)b * NMOD + col0;
            f32x4 gv[2][2], gs[2][2];
#pragma unroll
            for (int bj = 0; bj < 2; ++bj)
#pragma unroll
                for (int n = 0; n < 2; ++n) {
                    gv[bj][n] = *(const f32x4*)(gp + bj * 128 + n * 16) * coef;
                    if (an) gs[bj][n] = *(const f32x4*)(gn + col0 + bj * 128 + n * 16) * (*(const f32x4*)(scn + (size_t)b * NMOD + col0 + bj * 128 + n * 16) + 1.0f);
                }
#pragma unroll
            for (int mh = 0; mh < 2; ++mh) {
                f32x4 xv[2][2][2];
#pragma unroll
                for (int mi = 0; mi < 2; ++mi) {
                    const int row = u.pm * 256 + ai * 128 + wr * 64 + (2 * mh + mi) * 16 + fr;
                    const float* bp = (row < TP ? xa + (size_t)row * DM : xb + (size_t)(row - TP) * DM) + col0;
#pragma unroll
                    for (int bj = 0; bj < 2; ++bj)
#pragma unroll
                        for (int n = 0; n < 2; ++n) xv[mi][bj][n] = *(const f32x4*)(bp + bj * 128 + n * 16);
                }
#pragma unroll
                for (int mi = 0; mi < 2; ++mi) {
                    const int m = 2 * mh + mi;
                    const int row = u.pm * 256 + ai * 128 + wr * 64 + m * 16 + fr;
                    float* op = out + (size_t)row * DM + col0;
                    float sq = 0.f;
#pragma unroll
                    for (int bj = 0; bj < 2; ++bj)
#pragma unroll
                        for (int n = 0; n < 2; ++n) {
                            const f32x4 x = xv[mi][bj][n] + gv[bj][n] * acc[ai][bj][m][n];
                            *(f32x4*)(op + bj * 128 + n * 16) = x;
                            if (an) {
                                sq += x[0] * x[0] + x[1] * x[1] + x[2] * x[2] + x[3] * x[3];
                                const f32x4 y = x * gs[bj][n];
                                u32x2 w; w.x = cvt_pk_bf16(y[0], y[1]); w.y = cvt_pk_bf16(y[2], y[3]);
                                *(u32x2*)(an + (size_t)row * DM + col0 + bj * 128 + n * 16) = w;
                            }
                        }
                    if (an) { sq += __shfl_xor(sq, 16); sq += __shfl_xor(sq, 32); if (fq == 0) __hip_atomic_fetch_add(ssq + row, sq, __ATOMIC_RELAXED, __HIP_MEMORY_SCOPE_AGENT); }
                }
            }
        }
    }
};
struct EpiInproj {
    static constexpr bool PERM = true;
    unsigned char* big; const float* lbl; float* out; const float* ssq; const float* shw;
    __device__ __forceinline__ void store8(bf16_t* p, const f32x4& a, const f32x4& b) const {
        u32x4 w; w.x = cvt_pk_bf16(a[0], a[1]); w.y = cvt_pk_bf16(a[2], a[3]); w.z = cvt_pk_bf16(b[0], b[1]); w.w = cvt_pk_bf16(b[2], b[3]); *(u32x4*)p = w;
    }
    __device__ __forceinline__ void operator()(const f32x4 (&acc_)[2][2][4][2], const Unit& u, int wr, int wc, int fr, int fq) const {
        const int row0 = u.pm * 256 + wr * 64 + fr, cw = wc * 32 + 8 * fq;
        const int pn = u.pn;
        f32x4 acc[2][2][4][2];
#pragma unroll
        for (int ai = 0; ai < 2; ++ai) {
            const int b = u.pm < 256 ? (u.pm >> 4) : 16 + (u.pm - 256) * 4 + ai * 2 + wr;
            const float* sp = shw + (size_t)b * DIN + pn * 256 + cw;
            f32x4 sh[2][2];
#pragma unroll
            for (int bj = 0; bj < 2; ++bj) { sh[bj][0] = *(const f32x4*)(sp + bj * 128); sh[bj][1] = *(const f32x4*)(sp + bj * 128 + 4); }
#pragma unroll
            for (int m = 0; m < 4; ++m) {
                const float r = rsqrtf(ssq[row0 + ai * 128 + m * 16] * (1.0f / DM) + 1e-6f);
#pragma unroll
                for (int bj = 0; bj < 2; ++bj)
#pragma unroll
                    for (int n = 0; n < 2; ++n) acc[ai][bj][m][n] = acc_[ai][bj][m][n] * r + sh[bj][n];
            }
        }
        if (pn == 2 || pn == 3) {
            bf16_t* zk = (bf16_t*)(big + Z_K); float* zg = (float*)(big + Z_G);
#pragma unroll
            for (int bj = 0; bj < 2; ++bj) {
                const int cc = (pn - 2) * 256 + bj * 128 + cw;
                float lb[8];
#pragma unroll
                for (int j = 0; j < 8; ++j) lb[j] = 1.0f / (1.0f + __expf(lbl[512 + cc + j] - lbl[cc + j]));
#pragma unroll
                for (int ai = 0; ai < 2; ++ai)
#pragma unroll
                    for (int m = 0; m < 4; ++m) {
                        const size_t row = (size_t)(row0 + ai * 128 + m * 16);
                        f32x4 kk[2], gg[2];
#pragma unroll
                        for (int n = 0; n < 2; ++n)
#pragma unroll
                            for (int j = 0; j < 4; ++j) {
                                const float f = acc[ai][bj][m][n][j], l = lb[n * 4 + j];
                                const float e = __expf(-f), sg = __builtin_amdgcn_rcpf(1.0f + e);
                                const float forget = l + (1.0f - l) * sg;
                                kk[n][j] = (1.0f - l) * (1.0f - sg);
                                gg[n][j] = __logf(forget);
                            }
                        store8(zk + row * 512 + cc, kk[0], kk[1]);
                        *(f32x4*)(zg + row * 512 + cc) = gg[0]; *(f32x4*)(zg + row * 512 + cc + 4) = gg[1];
                    }
            }
        } else if (pn == 10) {
#pragma unroll
            for (int bj = 0; bj < 2; ++bj) {
                bf16_t* z = (bf16_t*)(big + (bj ? Z_SV : Z_SK));
#pragma unroll
                for (int ai = 0; ai < 2; ++ai) {
                    float* cp = nullptr;
                    if (u.pm < 256) { if ((u.pm & 15) == 15 && ai == 1) cp = out + (bj ? O_CVP : O_CKP) + (size_t)(u.pm >> 4) * 16384 + (size_t)(wr * 64) * 128; }
                    else cp = out + (bj ? O_CVS : O_CKS) + (size_t)((u.pm - 256) * 4 + ai * 2 + wr) * 16384 + (size_t)64 * 128;
#pragma unroll
                    for (int m = 0; m < 4; ++m) {
                        const size_t row = (size_t)(row0 + ai * 128 + m * 16);
                        store8(z + row * 128 + cw, acc[ai][bj][m][0], acc[ai][bj][m][1]);
                        if (cp) { float* q = cp + (size_t)(m * 16 + fr) * 128 + cw; *(f32x4*)q = acc[ai][bj][m][0]; *(f32x4*)(q + 4) = acc[ai][bj][m][1]; }
                    }
                }
            }
        } else {
            const bool isq = pn < 2 || pn == 6 || pn == 7;
            const size_t zoff = pn < 2 ? Z_Q : (pn < 6 ? Z_V : (pn < 8 ? Z_OG : Z_SQ));
            const int cbase = (pn & 1) * 256;
            bf16_t* z = (bf16_t*)(big + zoff);
#pragma unroll
            for (int bj = 0; bj < 2; ++bj)
#pragma unroll
                for (int ai = 0; ai < 2; ++ai)
#pragma unroll
                    for (int m = 0; m < 4; ++m) {
                        const size_t row = (size_t)(row0 + ai * 128 + m * 16);
                        f32x4 a = acc[ai][bj][m][0], b = acc[ai][bj][m][1];
                        if (isq) {
#pragma unroll
                            for (int j = 0; j < 4; ++j) { a[j] = fsilu(a[j]); b[j] = fsilu(b[j]); }
                        }
                        store8(z + row * 512 + cbase + bj * 128 + cw, a, b);
                    }
        }
    }
};

__device__ __forceinline__ void cvt_tile(const float* src, bf16_t* dst, int K, int N, int mode, int tile, LAS float* tl) {
    const int tid = threadIdx.x;
    const int ntn = N >> 6, tk = tile / ntn, tn = tile - tk * ntn, k0 = tk * 64, n0 = tn * 64;
#pragma unroll
    for (int i = 0; i < 2; ++i) {
        const int r = (tid >> 4) + 32 * i, c4 = (tid & 15) * 4;
        const f32x4 v = *(const f32x4*)(src + (size_t)(k0 + r) * N + n0 + c4);
        tl[r * 65 + c4 + 0] = v[0]; tl[r * 65 + c4 + 1] = v[1]; tl[r * 65 + c4 + 2] = v[2]; tl[r * 65 + c4 + 3] = v[3];
    }
    __syncthreads();
    const int n = tid >> 3, kq = tid & 7;
    float v[8];
#pragma unroll
    for (int j = 0; j < 8; ++j) v[j] = tl[(kq * 8 + j) * 65 + n];
    int nd = n0 + n;
    if (mode == 1) { if (nd < DFF) nd = 256 * (nd >> 7) + (nd & 127); else { const int uu = nd - DFF; nd = 256 * (uu >> 7) + 128 + (uu & 127); } }
    u32x4 w; w.x = cvt_pk_bf16(v[0], v[1]); w.y = cvt_pk_bf16(v[2], v[3]); w.z = cvt_pk_bf16(v[4], v[5]); w.w = cvt_pk_bf16(v[6], v[7]);
    *(u32x4*)(dst + (size_t)nd * K + k0 + kq * 8) = w;
    __syncthreads();
}

__device__ __forceinline__ void adaln_strip(const Params& p, int strip, LAS unsigned char* lds) {
    LAS float* sc = (LAS float*)lds;
    const int tid = threadIdx.x, col = tid & 63, kg = tid >> 6;
    float acc[NB];
#pragma unroll
    for (int b = 0; b < NB; ++b) acc[b] = 0.f;
    for (int ch = 0; ch < 4; ++ch) {
        __syncthreads();
        for (int e = tid; e < NB * 256; e += 512) {
            const int b = e >> 8, kk = e & 255;
            const float c = b < 16 ? p.c_p[b * DM + ch * 256 + kk] : p.c_s[(b - 16) * DM + ch * 256 + kk];
            sc[kk * NB + b] = c / (1.0f + expf(-c));
        }
        __syncthreads();
        for (int kk = 0; kk < 32; ++kk) {
            const int kl = kg * 32 + kk, k = ch * 256 + kl;
            const float w = p.w_ada[(size_t)k * NMOD + strip * 64 + col];
            const LAS f32x4* s4 = (const LAS f32x4*)(sc + kl * NB);
#pragma unroll
            for (int b4 = 0; b4 < NB / 4; ++b4) { const f32x4 s = s4[b4]; acc[4 * b4] += s[0] * w; acc[4 * b4 + 1] += s[1] * w; acc[4 * b4 + 2] += s[2] * w; acc[4 * b4 + 3] += s[3] * w; }
        }
    }
    __syncthreads();
    LAS float* red = (LAS float*)lds;
#pragma unroll
    for (int b = 0; b < NB; ++b) red[(kg * NB + b) * 64 + col] = acc[b];
    __syncthreads();
    float* mod = (float*)(p.ws + W_MOD);
    for (int e = tid; e < NB * 64; e += 512) {
        const int b = e >> 6, c = e & 63;
        float s = 0.f;
#pragma unroll
        for (int g = 0; g < 8; ++g) s += red[(g * NB + b) * 64 + c];
        mod[(size_t)b * NMOD + strip * 64 + c] = s + p.b_ada[strip * 64 + c];
    }
    __syncthreads();
}

__device__ __forceinline__ void phase0(const Params& p, LAS unsigned char* lds) {
    if (blockIdx.x < 144) adaln_strip(p, blockIdx.x, lds);
    {
        const size_t n4 = (size_t)32 * 64 * 128 / 4;
        for (size_t i = (size_t)blockIdx.x * 512 + threadIdx.x; i < 2 * n4; i += (size_t)gridDim.x * 512) {
            const int which = i >= n4; const size_t j = which ? i - n4 : i;
            const size_t sb = j / 2048, r = j % 2048;
            const f32x4 v = *(const f32x4*)((which ? p.cache_v : p.cache_k) + sb * 16384 + 8192 + r * 4);
            *(f32x4*)(p.out + (which ? O_CVS : O_CKS) + sb * 16384 + r * 4) = v;
        }
    }
    for (int i = blockIdx.x * 512 + threadIdx.x; i < 16384; i += gridDim.x * 512) ((float*)(p.ws + W_ZERO))[i] = 0.f;
    for (int i = blockIdx.x * 512 + threadIdx.x; i < 2 * T; i += gridDim.x * 512) ((float*)(p.ws + W_SSQ))[i] = 0.f;
    LAS float* tl = (LAS float*)lds;
    for (int t = blockIdx.x; t < 5184; t += gridDim.x) {
        if (t < 1408) cvt_tile(p.w_up1, (bf16_t*)(p.ws + W_UP1), DM, 2 * DFF, 1, t, tl);
        else if (t < 2112) cvt_tile(p.w_down1, (bf16_t*)(p.ws + W_DN1), DFF, DM, 0, t - 1408, tl);
        else if (t < 2816) cvt_tile(p.w_in, (bf16_t*)(p.ws + W_IN), DM, DIN, 0, t - 2112, tl);
        else if (t < 3072) cvt_tile(p.w_out, (bf16_t*)(p.ws + W_OUT), DM, DM, 0, t - 2816, tl);
        else if (t < 4480) cvt_tile(p.w_up2, (bf16_t*)(p.ws + W_UP2), DM, 2 * DFF, 1, t - 3072, tl);
        else cvt_tile(p.w_down2, (bf16_t*)(p.ws + W_DN2), DFF, DM, 0, t - 4480, tl);
    }
}

__device__ __forceinline__ float wave_sum(float v) {
#pragma unroll
    for (int o = 32; o > 0; o >>= 1) v += __shfl_xor(v, o);
    return v;
}
__device__ __forceinline__ void norm_mod_row(const f32x4 (&v)[4], const float* gvec, const float* mrow, int shift_idx, int scale_idx, bf16_t* hrow, int lane) {
    float ss = 0.f;
#pragma unroll
    for (int i = 0; i < 4; ++i) ss += v[i][0] * v[i][0] + v[i][1] * v[i][1] + v[i][2] * v[i][2] + v[i][3] * v[i][3];
    ss = wave_sum(ss);
    const float rstd = rsqrtf(ss * (1.0f / DM) + 1e-6f);
#pragma unroll
    for (int i = 0; i < 2; ++i) {
        const int c0 = i * 512 + lane * 8;
        float y[8];
#pragma unroll
        for (int q = 0; q < 2; ++q) {
            const f32x4 g = *(const f32x4*)(gvec + c0 + 4 * q), sc = *(const f32x4*)(mrow + scale_idx * DM + c0 + 4 * q), sh = *(const f32x4*)(mrow + shift_idx * DM + c0 + 4 * q);
#pragma unroll
            for (int j = 0; j < 4; ++j) y[4 * q + j] = v[2 * i + q][j] * rstd * g[j] * (1.0f + sc[j]) + sh[j];
        }
        u32x4 w; w.x = cvt_pk_bf16(y[0], y[1]); w.y = cvt_pk_bf16(y[2], y[3]); w.z = cvt_pk_bf16(y[4], y[5]); w.w = cvt_pk_bf16(y[6], y[7]);
        *(u32x4*)(hrow + c0) = w;
    }
}
__device__ __forceinline__ void norm_mod_phase(const float* xa, const float* xb, const float* gvec, const float* mod, int shift_idx, int scale_idx, bf16_t* h) {
    const int wid = threadIdx.x >> 6, lane = threadIdx.x & 63, stride = gridDim.x * 8;
    for (int row = blockIdx.x * 8 + wid; row < T; row += 2 * stride) {
        const int row2 = row + stride; const bool has2 = row2 < T; const int r2 = has2 ? row2 : row;
        const float* s1 = row < TP ? xa + (size_t)row * DM : xb + (size_t)(row - TP) * DM;
        const float* s2 = r2 < TP ? xa + (size_t)r2 * DM : xb + (size_t)(r2 - TP) * DM;
        f32x4 v1[4], v2[4];
#pragma unroll
        for (int i = 0; i < 2; ++i) { v1[2 * i] = *(const f32x4*)(s1 + i * 512 + lane * 8); v1[2 * i + 1] = *(const f32x4*)(s1 + i * 512 + lane * 8 + 4); }
#pragma unroll
        for (int i = 0; i < 2; ++i) { v2[2 * i] = *(const f32x4*)(s2 + i * 512 + lane * 8); v2[2 * i + 1] = *(const f32x4*)(s2 + i * 512 + lane * 8 + 4); }
        norm_mod_row(v1, gvec, mod + (size_t)batch_of_row(row) * NMOD, shift_idx, scale_idx, h + (size_t)row * DM, lane);
        if (has2) norm_mod_row(v2, gvec, mod + (size_t)batch_of_row(r2) * NMOD, shift_idx, scale_idx, h + (size_t)r2 * DM, lane);
    }
}
__device__ __forceinline__ void final_norm_phase(float* x, const float* gvec) {
    const int wid = threadIdx.x >> 6, lane = threadIdx.x & 63, stride = gridDim.x * 8;
    for (int row = blockIdx.x * 8 + wid; row < T; row += 2 * stride) {
        const int row2 = row + stride; const bool has2 = row2 < T; const int r2 = has2 ? row2 : row;
        float* s1 = x + (size_t)row * DM; float* s2 = x + (size_t)r2 * DM;
        f32x4 v1[4], v2[4];
#pragma unroll
        for (int i = 0; i < 4; ++i) v1[i] = *(const f32x4*)(s1 + i * 256 + lane * 4);
#pragma unroll
        for (int i = 0; i < 4; ++i) v2[i] = *(const f32x4*)(s2 + i * 256 + lane * 4);
        float ss1 = 0.f, ss2 = 0.f;
#pragma unroll
        for (int i = 0; i < 4; ++i) { ss1 += v1[i][0] * v1[i][0] + v1[i][1] * v1[i][1] + v1[i][2] * v1[i][2] + v1[i][3] * v1[i][3]; ss2 += v2[i][0] * v2[i][0] + v2[i][1] * v2[i][1] + v2[i][2] * v2[i][2] + v2[i][3] * v2[i][3]; }
        ss1 = wave_sum(ss1); ss2 = wave_sum(ss2);
        const float r1 = rsqrtf(ss1 * (1.0f / DM) + 1e-6f), r2s = rsqrtf(ss2 * (1.0f / DM) + 1e-6f);
#pragma unroll
        for (int i = 0; i < 4; ++i) { const f32x4 g = *(const f32x4*)(gvec + i * 256 + lane * 4); *(f32x4*)(s1 + i * 256 + lane * 4) = v1[i] * r1 * g; if (has2) *(f32x4*)(s2 + i * 256 + lane * 4) = v2[i] * r2s * g; }
    }
}

constexpr int HG_QS = 0, HG_KS = 17408, HG_KT = 34816, HG_VT = 53248, HG_AS = 71680, HG_ST = 80896, HG_DEC = 115712, HG_TOT = 116224, HG_SSQ = 118272;
__device__ __forceinline__ f32x4 mfma16(bf16x8 a, bf16x8 b, f32x4 c) { return __builtin_amdgcn_mfma_f32_16x16x32_bf16(a, b, c, 0, 0, 0); }

__device__ __forceinline__ void hgrn_unit(const Params& p, int row0, int nc, int h, const float* S0, float* Sout, int mode, float* Dout, LAS unsigned char* lds) {
    unsigned char* big = p.ws + W_BIG;
    bf16_t* zq = (bf16_t*)(big + Z_Q); const bf16_t* zk = (const bf16_t*)(big + Z_K); const bf16_t* zv = (const bf16_t*)(big + Z_V);
    const bf16_t* zog = (const bf16_t*)(big + Z_OG); float* zg = (float*)(big + Z_G);
    bf16_t* ymix = (bf16_t*)(p.ws + W_H);
    LAS bf16_t* Qs = (LAS bf16_t*)(lds + HG_QS); LAS bf16_t* Ks = (LAS bf16_t*)(lds + HG_KS); LAS bf16_t* Kt = (LAS bf16_t*)(lds + HG_KT);
    LAS bf16_t* Vt = (LAS bf16_t*)(lds + HG_VT); LAS bf16_t* As = (LAS bf16_t*)(lds + HG_AS); LAS bf16_t* St = (LAS bf16_t*)(lds + HG_ST);
    LAS float* dec = (LAS float*)(lds + HG_DEC); LAS float* tot = (LAS float*)(lds + HG_TOT); LAS float* ssq = (LAS float*)(lds + HG_SSQ);
    const int tid = threadIdx.x, wid = __builtin_amdgcn_readfirstlane(tid >> 6), lane = tid & 63, fr = lane & 15, fq = lane >> 4;
    const int sg = wid >> 1, kc0 = (wid & 1) << 6, kcol = kc0 + lane;
    const int ttile = wid & 3, half = wid >> 2;
    const int vs = lane, v8 = wid;
    const unsigned lo_e = (unsigned)lane, lo_v = (unsigned)lane * 512u;

    __syncthreads();
    f32x4 Sacc[8];
#pragma unroll
    for (int vt = 0; vt < 8; ++vt) {
        {
            const float* sp = S0 + (size_t)(16 * wid) * 128 + 16 * vt;
            const unsigned so = (unsigned)fq * 512u + fr;
            Sacc[vt] = (f32x4){sp[so], sp[so + 128], sp[so + 256], sp[so + 384]};
        }
        u32x2 w; w.x = cvt_pk_bf16(Sacc[vt][0], Sacc[vt][1]); w.y = cvt_pk_bf16(Sacc[vt][2], Sacc[vt][3]);
        *(LAS u32x2*)(St + (16 * vt + fr) * 136 + 16 * wid + 4 * fq) = w;
    }
    float gg[16]; bf16_t qq[16], kk[16]; u32x4 vv[2];
    {
        const size_t ub = ((size_t)row0 + 16 * sg) * 512 + h * 128 + kc0;
        const float* gp = zg + ub; const bf16_t* qp = zq + ub; const bf16_t* kp = zk + ub;
#pragma unroll
        for (int i = 0; i < 16; ++i) { gg[i] = gp[i * 512 + lo_e]; qq[i] = qp[i * 512 + lo_e]; kk[i] = kp[i * 512 + lo_e]; }
        const bf16_t* vp = zv + (size_t)row0 * 512 + h * 128 + v8 * 8;
#pragma unroll
        for (int i = 0; i < 2; ++i) vv[i] = *(const u32x4*)(vp + i * 64 + lo_v);
    }
    float ecum = 1.0f;
    for (int c = 0; c < nc; ++c) {
        const size_t rowc = (size_t)row0 + (size_t)c * 64;
#pragma unroll
        for (int i = 1; i < 16; ++i) gg[i] += gg[i - 1];
        tot[sg * 128 + kcol] = gg[15];
        __syncthreads();
        {
            const float t0 = tot[kcol], t1 = tot[128 + kcol], t2 = tot[256 + kcol], t3 = tot[384 + kcol];
            const float off = (sg > 0 ? t0 : 0.f) + (sg > 1 ? t1 : 0.f) + (sg > 2 ? t2 : 0.f);
            const float blast = (t0 + t1) + (t2 + t3);
            const float edec = __expf(blast);
            if (sg == 0) dec[kcol] = edec;
            unsigned kt[8];
#pragma unroll
            for (int i = 0; i < 16; i += 2) {
                float kt2[2];
#pragma unroll
                for (int j = 0; j < 2; ++j) {
                    const float bb = off + gg[i + j];
                    const float eb = __expf(bb), einv = __expf(-bb);
                    const float qf = bf2f(qq[i + j]) * eb, kh = bf2f(kk[i + j]) * einv;
                    kt2[j] = kh * edec;
                    const int s = 16 * sg + i + j;
                    Qs[s * 136 + kcol] = (bf16_t)(cvt_pk_bf16(qf, 0.f) & 0xffffu);
                    Ks[s * 136 + kcol] = (bf16_t)(cvt_pk_bf16(kh, 0.f) & 0xffffu);
                    if (mode) (zq + (rowc + 16 * sg) * 512 + h * 128 + kc0)[(i + j) * 512 + lo_e] = (bf16_t)(cvt_pk_bf16(qf * ecum, 0.f) & 0xffffu);
                }
                kt[i >> 1] = cvt_pk_bf16(kt2[0], kt2[1]);
            }
            ecum *= edec;
            *(LAS u32x4*)(Kt + kcol * 72 + 16 * sg) = (u32x4){kt[0], kt[1], kt[2], kt[3]};
            *(LAS u32x4*)(Kt + kcol * 72 + 16 * sg + 8) = (u32x4){kt[4], kt[5], kt[6], kt[7]};
#pragma unroll
            for (int i = 0; i < 2; ++i) {
                const int vb = (v8 + 8 * i) * 8;
#pragma unroll
                for (int j = 0; j < 4; ++j) { const unsigned w = vv[i][j]; Vt[(vb + 2 * j) * 72 + vs] = (bf16_t)(w & 0xffffu); Vt[(vb + 2 * j + 1) * 72 + vs] = (bf16_t)(w >> 16); }
            }
        }
        {
            const size_t rown = (size_t)row0 + (size_t)(c + 1 < nc ? c + 1 : c) * 64;
            const size_t ub = (rown + 16 * sg) * 512 + h * 128 + kc0;
            const float* gp = zg + ub; const bf16_t* qp = zq + ub; const bf16_t* kp = zk + ub;
#pragma unroll
            for (int i = 0; i < 16; ++i) { gg[i] = gp[i * 512 + lo_e]; qq[i] = qp[i * 512 + lo_e]; kk[i] = kp[i * 512 + lo_e]; }
            const bf16_t* vp = zv + rown * 512 + h * 128 + v8 * 8;
#pragma unroll
            for (int i = 0; i < 2; ++i) vv[i] = *(const u32x4*)(vp + i * 64 + lo_v);
        }
        u32x2 og[4];
        const int trow = 16 * ttile + fr;
        {
            const bf16_t* ogp = zog + (rowc + 16 * ttile) * 512 + h * 128 + 64 * half;
            const unsigned lo_o = (unsigned)fr * 512u + 4u * fq;
#pragma unroll
            for (int i = 0; i < 4; ++i) og[i] = *(const u32x2*)(ogp + 16 * i + lo_o);
        }
        __syncthreads();
        bf16x8 Qf[4];
#pragma unroll
        for (int k4 = 0; k4 < 4; ++k4) Qf[k4] = *(const LAS bf16x8*)(Qs + trow * 136 + 32 * k4 + 8 * fq);
#pragma unroll
        for (int si = 0; si < 2; ++si) {
            const int st = 2 * half + si;
            f32x4 a = (f32x4){0.f, 0.f, 0.f, 0.f};
            if (st <= ttile) {
#pragma unroll
                for (int k4 = 0; k4 < 4; ++k4) { const bf16x8 Kf = *(const LAS bf16x8*)(Ks + (16 * st + fr) * 136 + 32 * k4 + 8 * fq); a = mfma16(Kf, Qf[k4], a); }
#pragma unroll
                for (int r = 0; r < 4; ++r) a[r] = (16 * st + 4 * fq + r <= trow) ? a[r] : 0.f;
            }
            u32x2 w; w.x = cvt_pk_bf16(a[0], a[1]); w.y = cvt_pk_bf16(a[2], a[3]);
            *(LAS u32x2*)(As + trow * 72 + 16 * st + 4 * fq) = w;
        }
        __syncthreads();
        f32x4 Oacc[4];
        {
            bf16x8 Af[2];
#pragma unroll
            for (int k2 = 0; k2 < 2; ++k2) Af[k2] = *(const LAS bf16x8*)(As + trow * 72 + 32 * k2 + 8 * fq);
            float sq = 0.f;
#pragma unroll
            for (int i = 0; i < 4; ++i) {
                const int vrow = 16 * (4 * half + i) + fr;
                f32x4 a = (f32x4){0.f, 0.f, 0.f, 0.f};
#pragma unroll
                for (int k2 = 0; k2 < 2; ++k2) { const bf16x8 Vf = *(const LAS bf16x8*)(Vt + vrow * 72 + 32 * k2 + 8 * fq); a = mfma16(Vf, Af[k2], a); }
#pragma unroll
                for (int k4 = 0; k4 < 4; ++k4) { const bf16x8 Sf = *(const LAS bf16x8*)(St + vrow * 136 + 32 * k4 + 8 * fq); a = mfma16(Sf, Qf[k4], a); }
                Oacc[i] = a;
                sq += a[0] * a[0] + a[1] * a[1] + a[2] * a[2] + a[3] * a[3];
            }
            sq += __shfl_xor(sq, 16); sq += __shfl_xor(sq, 32);
            if (fq == 0) ssq[trow * 2 + half] = sq;
            const f32x4 dk = *(const LAS f32x4*)(dec + 16 * wid + 4 * fq);
            bf16x8 Ktf[2];
#pragma unroll
            for (int k2 = 0; k2 < 2; ++k2) Ktf[k2] = *(const LAS bf16x8*)(Kt + (16 * wid + fr) * 72 + 32 * k2 + 8 * fq);
#pragma unroll
            for (int vt = 0; vt < 8; ++vt) {
                f32x4 s = Sacc[vt] * dk;
#pragma unroll
                for (int k2 = 0; k2 < 2; ++k2) { const bf16x8 Vf = *(const LAS bf16x8*)(Vt + (16 * vt + fr) * 72 + 32 * k2 + 8 * fq); s = mfma16(Ktf[k2], Vf, s); }
                Sacc[vt] = s;
            }
        }
        __syncthreads();
#pragma unroll
        for (int vt = 0; vt < 8; ++vt) {
            u32x2 w; w.x = cvt_pk_bf16(Sacc[vt][0], Sacc[vt][1]); w.y = cvt_pk_bf16(Sacc[vt][2], Sacc[vt][3]);
            *(LAS u32x2*)(St + (16 * vt + fr) * 136 + 16 * wid + 4 * fq) = w;
        }
        if (mode == 0) {
            const float tots = ssq[trow * 2] + ssq[trow * 2 + 1];
            const float r = rsqrtf(tots * (1.0f / 128.0f) + 1e-6f);
#pragma unroll
            for (int i = 0; i < 4; ++i) {
                const f32x4 gn = *(const f32x4*)(p.g_hgrn + 16 * (4 * half + i) + 4 * fq);
                const float o0 = Oacc[i][0] * r * gn[0] * bf_lo(og[i].x), o1 = Oacc[i][1] * r * gn[1] * bf_hi(og[i].x);
                const float o2 = Oacc[i][2] * r * gn[2] * bf_lo(og[i].y), o3 = Oacc[i][3] * r * gn[3] * bf_hi(og[i].y);
                u32x2 w; w.x = cvt_pk_bf16(o0, o1); w.y = cvt_pk_bf16(o2, o3);
                *(u32x2*)(ymix + (rowc + 16 * ttile) * DM + h * 128 + 64 * half + 16 * i + ((unsigned)fr * 1024u + 4u * fq)) = w;
            }
        } else {
#pragma unroll
            for (int i = 0; i < 4; ++i) *(f32x4*)(zg + (rowc + 16 * ttile) * 512 + h * 128 + 64 * half + 16 * i + ((unsigned)fr * 512u + 4u * fq)) = Oacc[i];
        }
    }
#pragma unroll
    for (int vt = 0; vt < 8; ++vt)
#pragma unroll
        for (int r = 0; r < 4; ++r) Sout[(size_t)(16 * wid + 4 * fq + r) * 128 + 16 * vt + fr] = Sacc[vt][r];
    if (Dout && sg == 0) Dout[kcol] = ecum;
    __syncthreads();
}

__device__ __forceinline__ void hgrn_fix_unit(const Params& p, int bh, int seg, LAS unsigned char* lds) {
    const unsigned char* big = p.ws + W_BIG;
    const bf16_t* zq = (const bf16_t*)(big + Z_Q); const bf16_t* zog = (const bf16_t*)(big + Z_OG); const float* zg = (const float*)(big + Z_G);
    const float* sseg = (const float*)(p.ws + W_SSEG) + (size_t)bh * 4 * 16384; const float* dseg = (const float*)(p.ws + W_DSEG) + (size_t)bh * 4 * 128;
    bf16_t* ymix = (bf16_t*)(p.ws + W_H);
    LAS bf16_t* St = (LAS bf16_t*)(lds + HG_ST); LAS float* ssq = (LAS float*)(lds + HG_SSQ);
    const int tid = threadIdx.x, wid = __builtin_amdgcn_readfirstlane(tid >> 6), lane = tid & 63, fr = lane & 15, fq = lane >> 4;
    const int ttile = wid & 3, half = wid >> 2, trow = 16 * ttile + fr, h = bh & 3;
    const size_t row0 = (size_t)(bh >> 2) * 4096 + (size_t)seg * 1024;
    __syncthreads();
    {
        f32x4 S[8];
        const unsigned so = (unsigned)fq * 512u + fr;
#pragma unroll
        for (int vt = 0; vt < 8; ++vt) { const float* sp = sseg + (size_t)(16 * wid) * 128 + 16 * vt; S[vt] = (f32x4){sp[so], sp[so + 128], sp[so + 256], sp[so + 384]}; }
        for (int j = 1; j <= seg; ++j) {
            if (j == seg && seg != 3) break;
            const f32x4 d = *(const f32x4*)(dseg + j * 128 + 16 * wid + 4 * fq);
            if (j == seg) {
                float* so_ = p.out + O_STP + (size_t)bh * 16384;
#pragma unroll
                for (int vt = 0; vt < 8; ++vt) { const float* sp = sseg + (size_t)j * 16384 + (size_t)(16 * wid) * 128 + 16 * vt; float* op = so_ + (size_t)(16 * wid) * 128 + 16 * vt;
                    op[so] = d[0] * S[vt][0] + sp[so]; op[so + 128] = d[1] * S[vt][1] + sp[so + 128]; op[so + 256] = d[2] * S[vt][2] + sp[so + 256]; op[so + 384] = d[3] * S[vt][3] + sp[so + 384]; }
            } else {
#pragma unroll
                for (int vt = 0; vt < 8; ++vt) { const float* sp = sseg + (size_t)j * 16384 + (size_t)(16 * wid) * 128 + 16 * vt;
                    S[vt] = (f32x4){d[0] * S[vt][0] + sp[so], d[1] * S[vt][1] + sp[so + 128], d[2] * S[vt][2] + sp[so + 256], d[3] * S[vt][3] + sp[so + 384]}; }
            }
        }
#pragma unroll
        for (int vt = 0; vt < 8; ++vt) { u32x2 w; w.x = cvt_pk_bf16(S[vt][0], S[vt][1]); w.y = cvt_pk_bf16(S[vt][2], S[vt][3]); *(LAS u32x2*)(St + (16 * vt + fr) * 136 + 16 * wid + 4 * fq) = w; }
    }
    __syncthreads();
    bf16x8 Sf[4][4];
#pragma unroll
    for (int i = 0; i < 4; ++i)
#pragma unroll
        for (int k4 = 0; k4 < 4; ++k4) Sf[i][k4] = *(const LAS bf16x8*)(St + (16 * (4 * half + i) + fr) * 136 + 32 * k4 + 8 * fq);
    f32x4 gn[4];
#pragma unroll
    for (int i = 0; i < 4; ++i) gn[i] = *(const f32x4*)(p.g_hgrn + 16 * (4 * half + i) + 4 * fq);
    const unsigned lo_q = (unsigned)fr * 512u + 8u * fq, lo_o = (unsigned)fr * 512u + 4u * fq;
    for (int c = 0; c < 16; ++c) {
        const size_t rowt = row0 + (size_t)c * 64 + 16 * ttile;
        bf16x8 Qf[4]; f32x4 acc[4]; u32x2 og[4];
#pragma unroll
        for (int k4 = 0; k4 < 4; ++k4) Qf[k4] = *(const bf16x8*)(zq + rowt * 512 + h * 128 + 32 * k4 + lo_q);
#pragma unroll
        for (int i = 0; i < 4; ++i) { acc[i] = *(const f32x4*)(zg + rowt * 512 + h * 128 + 64 * half + 16 * i + lo_o); og[i] = *(const u32x2*)(zog + rowt * 512 + h * 128 + 64 * half + 16 * i + lo_o); }
        float sq = 0.f;
#pragma unroll
        for (int i = 0; i < 4; ++i) {
#pragma unroll
            for (int k4 = 0; k4 < 4; ++k4) acc[i] = mfma16(Sf[i][k4], Qf[k4], acc[i]);
            sq += acc[i][0] * acc[i][0] + acc[i][1] * acc[i][1] + acc[i][2] * acc[i][2] + acc[i][3] * acc[i][3];
        }
        sq += __shfl_xor(sq, 16); sq += __shfl_xor(sq, 32);
        LAS float* sp = ssq + (c & 1) * 128;
        if (fq == 0) sp[trow * 2 + half] = sq;
        __syncthreads();
        const float r = rsqrtf((sp[trow * 2] + sp[trow * 2 + 1]) * (1.0f / 128.0f) + 1e-6f);
#pragma unroll
        for (int i = 0; i < 4; ++i) {
            const float o0 = acc[i][0] * r * gn[i][0] * bf_lo(og[i].x), o1 = acc[i][1] * r * gn[i][1] * bf_hi(og[i].x);
            const float o2 = acc[i][2] * r * gn[i][2] * bf_lo(og[i].y), o3 = acc[i][3] * r * gn[i][3] * bf_hi(og[i].y);
            u32x2 w; w.x = cvt_pk_bf16(o0, o1); w.y = cvt_pk_bf16(o2, o3);
            *(u32x2*)(ymix + rowt * DM + h * 128 + 64 * half + 16 * i + ((unsigned)fr * 1024u + 4u * fq)) = w;
        }
    }
    __syncthreads();
}

constexpr int AT_KS = 0, AT_VT = 27648;
__device__ __forceinline__ void attn_unit(const Params& p, int a, LAS unsigned char* lds) {
    const unsigned char* big = p.ws + W_BIG;
    const bf16_t* zsq = (const bf16_t*)(big + Z_SQ); const bf16_t* zsk = (const bf16_t*)(big + Z_SK); const bf16_t* zsv = (const bf16_t*)(big + Z_SV);
    bf16_t* ymix = (bf16_t*)(p.ws + W_H);
    LAS bf16_t* Ks = (LAS bf16_t*)(lds + AT_KS); LAS bf16_t* Vt = (LAS bf16_t*)(lds + AT_VT);
    const int tid = threadIdx.x, wid = tid >> 6, lane = tid & 63, fr = lane & 15, fq = lane >> 4;
    int kvh, jb0; size_t row0; bool sample; int sb = 0, bb = 0, cc = 0;
    if (a < 2048) { bb = a >> 7; cc = (a >> 1) & 63; kvh = a & 1; row0 = (size_t)bb * 4096 + (size_t)cc * 64; jb0 = cc >= 2 ? 0 : 2 - cc; sample = false; }
    else { const int s2 = a - 2048; sb = s2 >> 1; kvh = s2 & 1; row0 = (size_t)TP + (size_t)sb * 64; jb0 = 0; sample = true; }
    __syncthreads();
    for (int jb = jb0; jb < 3; ++jb) {
        const int ks = tid >> 3, kd8 = tid & 7;
        const int vsx = tid & 63, vd8 = tid >> 6;
        u32x4 kw, vw;
        if (sample && jb < 2) {
            const float* kp = p.cache_k + ((size_t)(sb * 128 + jb * 64 + ks) * 2 + kvh) * 64 + kd8 * 8;
            const float* vp = p.cache_v + ((size_t)(sb * 128 + jb * 64 + vsx) * 2 + kvh) * 64 + vd8 * 8;
            const f32x4 k0 = *(const f32x4*)kp, k1 = *(const f32x4*)(kp + 4), v0 = *(const f32x4*)vp, v1 = *(const f32x4*)(vp + 4);
            kw = (u32x4){cvt_pk_bf16(k0[0], k0[1]), cvt_pk_bf16(k0[2], k0[3]), cvt_pk_bf16(k1[0], k1[1]), cvt_pk_bf16(k1[2], k1[3])};
            vw = (u32x4){cvt_pk_bf16(v0[0], v0[1]), cvt_pk_bf16(v0[2], v0[3]), cvt_pk_bf16(v1[0], v1[1]), cvt_pk_bf16(v1[2], v1[3])};
        } else {
            const size_t kr = sample ? row0 : row0 - 128 + (size_t)jb * 64;
            kw = *(const u32x4*)(zsk + (kr + ks) * 128 + kvh * 64 + kd8 * 8);
            vw = *(const u32x4*)(zsv + (kr + vsx) * 128 + kvh * 64 + vd8 * 8);
        }
        *(LAS u32x4*)(Ks + (jb * 64 + ks) * 72 + kd8 * 8) = kw;
#pragma unroll
        for (int j = 0; j < 4; ++j) { const unsigned w = vw[j]; Vt[(vd8 * 8 + 2 * j) * 200 + jb * 64 + vsx] = (bf16_t)(w & 0xffffu); Vt[(vd8 * 8 + 2 * j + 1) * 200 + jb * 64 + vsx] = (bf16_t)(w >> 16); }
    }
    __syncthreads();
#pragma unroll 1
    for (int task = wid; task < 16; task += 8) {
        const int gi = task >> 2, tt = task & 3, hh = kvh * 4 + gi;
        const int t = 16 * tt + fr;
        const float slope = exp2f(-(float)(hh + 1)), sink = p.sinks[hh];
        bf16x8 Qf[2];
#pragma unroll
        for (int kd = 0; kd < 2; ++kd) Qf[kd] = *(const bf16x8*)(zsq + (row0 + t) * 512 + hh * 64 + 32 * kd + 8 * fq);
        f32x4 sc[12];
        float mx = sink;
#pragma unroll
        for (int tile = 0; tile < 12; ++tile) {
            if (tile >= 4 * jb0) {
                f32x4 acc = (f32x4){0.f, 0.f, 0.f, 0.f};
#pragma unroll
                for (int kd = 0; kd < 2; ++kd) { const bf16x8 Kf = *(const LAS bf16x8*)(Ks + (16 * tile + fr) * 72 + 32 * kd + 8 * fq); acc = mfma16(Kf, Qf[kd], acc); }
#pragma unroll
                for (int r = 0; r < 4; ++r) {
                    const int s = 16 * tile + 4 * fq + r;
                    const float d = fabsf((float)(t + 128 - s));
                    acc[r] = acc[r] * 0.125f - slope * d;
                    mx = fmaxf(mx, acc[r]);
                }
                sc[tile] = acc;
            } else sc[tile] = (f32x4){-INFINITY, -INFINITY, -INFINITY, -INFINITY};
        }
        mx = fmaxf(mx, __shfl_xor(mx, 16)); mx = fmaxf(mx, __shfl_xor(mx, 32));
        float l = 0.f;
#pragma unroll
        for (int tile = 0; tile < 12; ++tile)
#pragma unroll
            for (int r = 0; r < 4; ++r) { const float e = __expf(sc[tile][r] - mx); sc[tile][r] = e; l += e; }
        l += __shfl_xor(l, 16); l += __shfl_xor(l, 32);
        l += __expf(sink - mx);
        const float rl = 1.0f / l;
        f32x4 o[4];
#pragma unroll
        for (int dt = 0; dt < 4; ++dt) o[dt] = (f32x4){0.f, 0.f, 0.f, 0.f};
#pragma unroll
        for (int k6 = 0; k6 < 6; ++k6) {
            if (k6 >= 2 * jb0) {
                union { u32x4 u; bf16x8 b; } pf;
                pf.u = (u32x4){cvt_pk_bf16(sc[2 * k6][0], sc[2 * k6][1]), cvt_pk_bf16(sc[2 * k6][2], sc[2 * k6][3]), cvt_pk_bf16(sc[2 * k6 + 1][0], sc[2 * k6 + 1][1]), cvt_pk_bf16(sc[2 * k6 + 1][2], sc[2 * k6 + 1][3])};
#pragma unroll
                for (int dt = 0; dt < 4; ++dt) {
                    union { u32x4 u; bf16x8 b; } vf;
                    const u32x2 lo = *(const LAS u32x2*)(Vt + (16 * dt + fr) * 200 + 32 * k6 + 4 * fq), hi = *(const LAS u32x2*)(Vt + (16 * dt + fr) * 200 + 32 * k6 + 16 + 4 * fq);
                    vf.u = (u32x4){lo.x, lo.y, hi.x, hi.y};
                    o[dt] = mfma16(vf.b, pf.b, o[dt]);
                }
            }
        }
#pragma unroll
        for (int dt = 0; dt < 4; ++dt) {
            u32x2 w; w.x = cvt_pk_bf16(o[dt][0] * rl, o[dt][1] * rl); w.y = cvt_pk_bf16(o[dt][2] * rl, o[dt][3] * rl);
            *(u32x2*)(ymix + (row0 + t) * DM + 512 + hh * 64 + 16 * dt + 4 * fq) = w;
        }
    }
}

__device__ __forceinline__ void mixer_phase_a(const Params& p, LAS unsigned char* lds) {
    for (int u = blockIdx.x; u < 256; u += gridDim.x) {
        const int bh = u >> 2, seg = u & 3, b = bh >> 2, h = bh & 3;
        hgrn_unit(p, b * 4096 + seg * 1024, 16, h, (const float*)(p.ws + W_ZERO), (float*)(p.ws + W_SSEG) + (size_t)u * 16384, seg ? 1 : 0,
                  (float*)(p.ws + W_DSEG) + (size_t)u * 128, lds);
    }
}
__device__ __forceinline__ void mixer_phase_b(const Params& p, LAS unsigned char* lds) {
    for (int it = blockIdx.x; it < 192 + 2112 + 128; it += gridDim.x) {
        if (it < 192) hgrn_fix_unit(p, it / 3, 1 + it % 3, lds);
        else if (it < 192 + 2112) attn_unit(p, it - 192, lds);
        else { const int su = it - 192 - 2112, sb = su >> 2, h = su & 3; hgrn_unit(p, TP + sb * 64, 1, h, p.state + (size_t)su * 16384, p.out + O_STS + (size_t)su * 16384, 0, nullptr, lds); }
    }
}

__global__ void __launch_bounds__(512, 2) mk_fwd(Params p) {
    extern __shared__ __attribute__((aligned(16))) unsigned char lds_raw[];
    LAS unsigned char* lds = (LAS unsigned char*)lds_raw;
    cg::grid_group grid = cg::this_grid();
    float* mod = (float*)(p.ws + W_MOD);
    bf16_t* hbuf = (bf16_t*)(p.ws + W_H);
    bf16_t* hidden = (bf16_t*)(p.ws + W_BIG);
    float* xres = p.out + O_Y;
    pg8::StaticOrder so;
#ifndef PH_MASK
#define PH_MASK 0x7FF
#endif
#define PHASE_BEGIN(i) if (((PH_MASK >> (i)) & 1) && p.ph_lo <= (i) && (i) < p.ph_hi) { if ((i) > p.ph_lo) grid.sync();
#define PHASE_END }
    bf16_t* hb2 = (bf16_t*)(p.ws + W_HB2);
    float* ssq2 = (float*)(p.ws + W_SSQ); float* ssq3 = ssq2 + T;
    float* shwi = (float*)(p.ws + W_SHWI); float* shwu = (float*)(p.ws + W_SHWU);
    bf16_t* ash = (bf16_t*)(p.ws + W_ASH);
    PHASE_BEGIN(0) phase0(p, lds); PHASE_END
    PHASE_BEGIN(1) {
        norm_mod_phase(p.x_p, p.x_s, p.g_ffn1, mod, 0, 1, hbuf);
        for (int i = blockIdx.x * 512 + threadIdx.x; i < 2 * 256 * DM; i += gridDim.x * 512) {
            const int w = i / (256 * DM), r = (i / DM) & 255, k = i & (DM - 1);
            ash[i] = r < NB ? (bf16_t)(cvt_pk_bf16(mod[(size_t)r * NMOD + (w ? 6 : 3) * DM + k], 0.f) & 0xffffu) : (bf16_t)0;
        }
    } PHASE_END
    PHASE_BEGIN(2) {
        { so.init(T, 2 * DFF, gridDim.x, blockIdx.x); pg8::Gemm g{hbuf, (const bf16_t*)(p.ws + W_UP1), T, 2 * DFF, DM}; EpiSwiglu e{hidden, nullptr, nullptr}; pg8::gemm_phase(lds, g, so, e); }
        { so.init(256, DIN, gridDim.x, (blockIdx.x + 80) & 255); pg8::Gemm g{ash, (const bf16_t*)(p.ws + W_IN), 256, DIN, DM}; EpiPlainF32 e{shwi, DIN}; pg8::gemm_phase(lds, g, so, e); }
        { so.init(256, 2 * DFF, gridDim.x, (blockIdx.x + 69) & 255); pg8::Gemm g{ash + 256 * DM, (const bf16_t*)(p.ws + W_UP2), 256, 2 * DFF, DM}; EpiPlainF32 e{shwu, 2 * DFF}; pg8::gemm_phase(lds, g, so, e); }
    } PHASE_END
    PHASE_BEGIN(3) { so.init(T, DM, gridDim.x, blockIdx.x); pg8::Gemm g{hidden, (const bf16_t*)(p.ws + W_DN1), T, DM, DFF}; EpiResid e{p.x_p, p.x_s, xres, mod + 2 * DM, hbuf, p.g_mix, mod + 4 * DM, ssq2, 0.5f, 0}; pg8::gemm_phase(lds, g, so, e); } PHASE_END
    PHASE_BEGIN(4) { so.init(T, DIN, gridDim.x, blockIdx.x); pg8::Gemm g{hbuf, (const bf16_t*)(p.ws + W_IN), T, DIN, DM}; EpiInproj e{p.ws + W_BIG, p.lb_logits, p.out, ssq2, shwi}; pg8::gemm_phase(lds, g, so, e); } PHASE_END
    PHASE_BEGIN(5) mixer_phase_a(p, lds); PHASE_END
    PHASE_BEGIN(6) mixer_phase_b(p, lds); PHASE_END
    PHASE_BEGIN(7) { so.init(T, DM, gridDim.x, blockIdx.x); pg8::Gemm g{hbuf, (const bf16_t*)(p.ws + W_OUT), T, DM, DM}; EpiResid e{xres, xres + (size_t)TP * DM, xres, mod + 5 * DM, hb2, p.g_ffn2, mod + 7 * DM, ssq3, 1.0f, 0}; pg8::gemm_phase(lds, g, so, e); } PHASE_END
    PHASE_BEGIN(8) { so.init(T, 2 * DFF, gridDim.x, blockIdx.x); pg8::Gemm g{hb2, (const bf16_t*)(p.ws + W_UP2), T, 2 * DFF, DM}; EpiSwiglu e{hidden, ssq3, shwu}; pg8::gemm_phase(lds, g, so, e); } PHASE_END
    PHASE_BEGIN(9) { so.init(T, DM, gridDim.x, blockIdx.x); pg8::Gemm g{hidden, (const bf16_t*)(p.ws + W_DN2), T, DM, DFF}; EpiResid e{xres, xres + (size_t)TP * DM, xres, mod + 8 * DM, nullptr, nullptr, nullptr, nullptr, 0.5f, 0}; pg8::gemm_phase(lds, g, so, e); } PHASE_END
    PHASE_BEGIN(10) final_norm_phase(xres, p.g_final); PHASE_END
}

extern "C" void kernel_launch(void* const* d_in, const int* in_sizes, int n_in, void* d_out, int out_size, void* d_ws, size_t ws_size, hipStream_t stream) {
    static int grid_blocks = 0;
    if (!grid_blocks) {
        int dev = 0, cus = 0, per_cu = 0;
        hipGetDevice(&dev);
        hipDeviceGetAttribute(&cus, hipDeviceAttributeMultiprocessorCount, dev);
        hipFuncSetAttribute((const void*)mk_fwd, hipFuncAttributeMaxDynamicSharedMemorySize, LDS_BYTES);
        hipOccupancyMaxActiveBlocksPerMultiprocessor(&per_cu, (const void*)mk_fwd, 512, LDS_BYTES);
        if (per_cu < 1) per_cu = 1;
        grid_blocks = cus * per_cu;
        if (grid_blocks > 256) grid_blocks = 256;
        if (ws_size < WS_NEED) fprintf(stderr, "kernel_launch: workspace too small: %zu < %zu\n", ws_size, (size_t)WS_NEED);
    }
    Params p{};
    const float** pp = (const float**)&p;
    for (int i = 0; i < 22; ++i) pp[i] = (const float*)d_in[i];
    p.out = (float*)d_out; p.ws = (unsigned char*)d_ws;
#if MK_LAUNCHES == 1
    p.ph_lo = 0; p.ph_hi = NPHASE;
    void* args[] = {&p};
    hipError_t e = hipLaunchCooperativeKernel((const void*)mk_fwd, dim3(grid_blocks), dim3(512), args, LDS_BYTES, stream);
    if (e != hipSuccess) fprintf(stderr, "cooperative launch failed: %s (grid %d)\n", hipGetErrorString(e), grid_blocks);
#else
    for (int i = 0; i < NPHASE; ++i) { p.ph_lo = i; p.ph_hi = i + 1; hipLaunchKernelGGL(mk_fwd, dim3(grid_blocks), dim3(512), LDS_BYTES, stream, p); }
#endif
}
```

```cpp
#include <hip/hip_runtime.h>
#include <hip/hip_cooperative_groups.h>
#include <cstdio>
namespace cg = cooperative_groups;

#ifndef MK_LAUNCHES
#define MK_LAUNCHES 1
#endif

#define LAS __attribute__((address_space(3)))
typedef unsigned short bf16_t;
typedef short bf16x8 __attribute__((ext_vector_type(8)));
typedef float f32x4 __attribute__((ext_vector_type(4)));
typedef unsigned u32x4 __attribute__((ext_vector_type(4)));
typedef unsigned u32x2 __attribute__((ext_vector_type(2)));

constexpr int TP = 65536, TS = 2048, T = TP + TS, DM = 1024, DFF = 2816, DIN = 2816, NB = 48, NMOD = 9216;
constexpr int LDS_BYTES = 131072 + 8192;
constexpr int NPHASE = 14;

constexpr size_t O_Y = 0, O_STP = (size_t)T * DM, O_CKP = O_STP + 16 * 4 * 16384, O_CVP = O_CKP + 16 * 16384, O_STS = O_CVP + 16 * 16384,
                 O_CKS = O_STS + 32 * 4 * 16384, O_CVS = O_CKS + 32 * 16384;
constexpr size_t W_UP1 = 0, W_DN1 = W_UP1 + (size_t)2 * DFF * DM * 2, W_IN = W_DN1 + (size_t)DM * DFF * 2, W_OUT = W_IN + (size_t)DIN * DM * 2,
                 W_UP2 = W_OUT + (size_t)DM * DM * 2, W_DN2 = W_UP2 + (size_t)2 * DFF * DM * 2, W_MOD = W_DN2 + (size_t)DM * DFF * 2,
                 W_ZERO = W_MOD + (size_t)NB * NMOD * 4, W_H = W_ZERO + 65536, W_BIG = W_H + (size_t)T * DM * 2;
constexpr size_t Z_Q = 0, Z_K = Z_Q + (size_t)T * 512 * 2, Z_V = Z_K + (size_t)T * 512 * 2, Z_OG = Z_V + (size_t)T * 512 * 2, Z_SQ = Z_OG + (size_t)T * 512 * 2,
                 Z_G = Z_SQ + (size_t)T * 512 * 2, Z_SK = Z_G + (size_t)T * 512 * 4, Z_SV = Z_SK + (size_t)T * 128 * 2, Z_END = Z_SV + (size_t)T * 128 * 2;
constexpr size_t W_SSEG = W_BIG + Z_END, W_DSEG = W_SSEG + (size_t)64 * 4 * 16384 * 4, W_HB2 = W_DSEG + (size_t)64 * 4 * 128 * 4, W_SSQ = W_HB2 + (size_t)T * DM * 2  , W_SHWI = W_SSQ + (size_t)3 * T * 4  ,
                 W_SHWU = W_SHWI + (size_t)256 * DIN * 4  , W_ASH = W_SHWU + (size_t)256 * 2 * DFF * 4  , W_BAR = W_ASH + (size_t)2 * 256 * DM * 2  , W_ZG = W_BAR + 16384  ,
                 WS_NEED = W_ZG + (size_t)T * 512 * 4;
constexpr size_t Z_G2 = W_ZG - W_BIG;

struct Params {
    const float *x_p, *x_s, *state, *cache_k, *cache_v, *c_p, *c_s, *w_ada, *b_ada, *g_ffn1, *w_up1, *w_down1, *g_mix, *w_in, *lb_logits, *g_hgrn, *sinks, *w_out,
        *g_ffn2, *w_up2, *w_down2, *g_final;
    float* out;
    unsigned char* ws;
    int ph_lo, ph_hi;
};

typedef float f32x2 __attribute__((ext_vector_type(2)));
typedef __bf16 bf16x2_t __attribute__((ext_vector_type(2)));
__device__ __forceinline__ unsigned cvt_pk_bf16(float lo, float hi) { const f32x2 v = {lo, hi}; return __builtin_bit_cast(unsigned, __builtin_convertvector(v, bf16x2_t)); }
__device__ __forceinline__ float bf_lo(unsigned w) { return __uint_as_float(w << 16); }
__device__ __forceinline__ float bf_hi(unsigned w) { return __uint_as_float(w & 0xffff0000u); }
__device__ __forceinline__ float bf2f(bf16_t b) { return __uint_as_float(((unsigned)b) << 16); }
__device__ __forceinline__ float fsilu(float v) { return v * __builtin_amdgcn_rcpf(1.0f + __expf(-v)); }
__device__ __forceinline__ int batch_of_row(int row) { return row < TP ? (row >> 12) : 16 + ((row - TP) >> 6); }

namespace pg8 {
constexpr int BM = 256, BK = 64, HALF = 128, HTB = HALF * BK * 2, STAGE_BYTES = 8 * HTB, NXCD = 8, WGM = 8;
__device__ __forceinline__ int lds_byte(int r, int c) { const int st = (r >> 4) * 2 + (c >> 5), rr = r & 15, cc = c & 31, ob = rr * 64 + cc * 2; return st * 1024 + (ob ^ (((ob >> 9) & 1) << 5)); }
__device__ __forceinline__ void stage_rc(int b, int& R, int& C) { const int st = b / 1024, sb = b % 1024, swz = sb ^ (((sb >> 9) & 1) << 5); R = (st >> 1) * 16 + swz / 64; C = (st & 1) * 32 + (swz % 64) / 2; }
__device__ __forceinline__ int perm32(int rho) { const int n = rho >> 4, i = rho & 15; return 8 * (i >> 2) + 4 * n + (i & 3); }
struct Unit { int pm, pn; };
struct Gemm { const bf16_t* A; const bf16_t* Bt; int M, N, K; };
struct StaticOrder {
    int nM, nN, nwg, G, c, pm0, L0, L1;
    __device__ void init(int M, int N, int G_, int c_, int pm0_ = 0) { nM = M / BM; nN = N / BM; nwg = nM * nN; G = G_; c = c_; pm0 = pm0_; L0 = 0; L1 = nwg; }
    __device__ void range(int a, int b) { L0 = a; L1 = b; }
    __device__ bool next(int i, Unit& u) const {
        const long L = (long)L0 + (long)i * G + c; if (L >= L1) return false;
        int wgid = (int)L; { const int q = nwg / NXCD, r = nwg % NXCD, xcd = wgid % NXCD, off = wgid / NXCD; wgid = (xcd < r ? xcd * (q + 1) : r * (q + 1) + (xcd - r) * q) + off; }
        const int nig = WGM * nN, gid = wgid / nig, fm = gid * WGM, gsz = (nM - fm) < WGM ? (nM - fm) : WGM;
        u.pm = pm0 + fm + ((wgid % nig) % gsz); u.pn = (wgid % nig) / gsz; return true;
    }
};

template <class Epi>
__device__ __forceinline__ void gemm_phase(LAS unsigned char* lds, const Gemm g, const StaticOrder& S, const Epi& E) {
    const int tid = threadIdx.x, wid = __builtin_amdgcn_readfirstlane(tid >> 6), lane = tid & 63, wr = wid >> 2, wc = wid & 3, fr = lane & 15, fq = lane >> 4;
    const int K = g.K, nt = K / BK;
    unsigned voffA[2], voffB[2];
#pragma unroll
    for (int i = 0; i < 2; ++i) { int R, C; stage_rc(tid * 16 + i * 8192, R, C); const int Rb = Epi::PERM ? ((R & ~31) + perm32(R & 31)) : R;
        voffA[i] = (unsigned)(R * K + C) * 2u; voffB[i] = (unsigned)(Rb * K + C) * 2u; }
    const size_t kstep = (size_t)(BK * 2);
    const size_t hstep = (size_t)HALF * K * 2;
    const size_t tstep = 2 * hstep;
    const unsigned ldsw = (unsigned)wid * 1024u;
    const int aoff = lds_byte(wr * 64 + fr, fq * 8), boff = lds_byte(wc * 32 + fr, fq * 8);
#define PG8_SA(b, h) (((b) * 2 + (h)) * HTB)
#define PG8_SB(b, h) ((4 + (b) * 2 + (h)) * HTB)
#define PG8_STAGE(bufoff, gbase, voff) do { _Pragma("unroll") for (int _i = 0; _i < 2; ++_i) \
        __builtin_amdgcn_global_load_lds((const unsigned*)((const char*)(gbase) + (voff)[_i]), (LAS unsigned*)(lds + (bufoff) + ldsw + _i * 8192), 16, 0, 0); } while (0)
#define PG8_LDA(dst, b, h) do { _Pragma("unroll") for (int m = 0; m < 4; ++m) _Pragma("unroll") for (int k = 0; k < 2; ++k) dst[m][k] = *(const LAS bf16x8*)(lds + PG8_SA(b, h) + aoff + m * 2048 + k * 1024); } while (0)
#define PG8_LDB(dst, b, h) do { _Pragma("unroll") for (int n = 0; n < 2; ++n) _Pragma("unroll") for (int k = 0; k < 2; ++k) dst[n][k] = *(const LAS bf16x8*)(lds + PG8_SB(b, h) + boff + n * 2048 + k * 1024); } while (0)
#define PG8_MMA(ai, bj, At, Bt) do { __builtin_amdgcn_s_setprio(1); _Pragma("unroll") for (int m = 0; m < 4; ++m) _Pragma("unroll") for (int n = 0; n < 2; ++n) _Pragma("unroll") for (int k = 0; k < 2; ++k) \
        acc[ai][bj][m][n] = __builtin_amdgcn_mfma_f32_16x16x32_bf16(Bt[n][k], At[m][k], acc[ai][bj][m][n], 0, 0, 0); __builtin_amdgcn_s_setprio(0); } while (0)
#define PG8_WAIT_V(n) asm volatile("s_waitcnt vmcnt(" #n ")" ::: "memory")
#define PG8_WAIT_L(n) asm volatile("s_waitcnt lgkmcnt(" #n ")" ::: "memory")
#define PG8_BAR __builtin_amdgcn_s_barrier()
#define PG8_SCHED __builtin_amdgcn_sched_barrier(0)
    Unit cur, nxt; int ui = 0;
    if (!S.next(0, cur)) return;
    f32x4 acc[2][2][4][2];
#pragma unroll
    for (int a = 0; a < 2; ++a)
#pragma unroll
        for (int b = 0; b < 2; ++b)
#pragma unroll
            for (int m = 0; m < 4; ++m)
#pragma unroll
                for (int n = 0; n < 2; ++n) acc[a][b][m][n] = (f32x4){0.f, 0.f, 0.f, 0.f};
    bf16x8 At[4][2], B0[2][2], B1[2][2];
    const char* cA = (const char*)g.A + (size_t)cur.pm * tstep; const char* cB = (const char*)g.Bt + (size_t)cur.pn * tstep;
    PG8_STAGE(PG8_SB(0, 0), cB, voffB); PG8_STAGE(PG8_SA(0, 0), cA, voffA); PG8_STAGE(PG8_SB(0, 1), cB + hstep, voffB); PG8_STAGE(PG8_SA(0, 1), cA + hstep, voffA);
    if (wr == 1) PG8_BAR;
    PG8_WAIT_V(4); PG8_BAR;
    PG8_STAGE(PG8_SB(1, 0), cB + kstep, voffB); PG8_STAGE(PG8_SA(1, 0), cA + kstep, voffA); PG8_STAGE(PG8_SB(1, 1), cB + hstep + kstep, voffB);
    PG8_WAIT_V(6); PG8_BAR;
    for (;;) {
        const bool has_next = S.next(ui + 1, nxt);
        const char* nA = has_next ? (const char*)g.A + (size_t)nxt.pm * tstep : cA; const char* nB = has_next ? (const char*)g.Bt + (size_t)nxt.pn * tstep : cB;
        for (int t = 0; t < nt; t += 2) {
            const bool last = (t == nt - 2);
            const char* a1 = cA + (size_t)(t + 1) * kstep;
            const char* a2 = last ? nA : cA + (size_t)(t + 2) * kstep; const char* b2 = last ? nB : cB + (size_t)(t + 2) * kstep;
            const char* a3 = a2 + kstep; const char* b3 = b2 + kstep;
            PG8_LDB(B0, 0, 0); PG8_SCHED; PG8_LDA(At, 0, 0); PG8_STAGE(PG8_SA(1, 1), a1 + hstep, voffA);
            PG8_WAIT_L(8); PG8_BAR; PG8_WAIT_L(0); PG8_MMA(0, 0, At, B0); PG8_BAR; PG8_SCHED;
            PG8_LDB(B1, 0, 1); PG8_STAGE(PG8_SB(0, 0), b2, voffB);
            PG8_BAR; PG8_WAIT_L(0); PG8_MMA(0, 1, At, B1); PG8_BAR;
            PG8_LDA(At, 0, 1); PG8_STAGE(PG8_SA(0, 0), a2, voffA);
            PG8_BAR; PG8_WAIT_L(0); PG8_MMA(1, 0, At, B0); PG8_BAR; PG8_SCHED;
            PG8_STAGE(PG8_SB(0, 1), b2 + hstep, voffB);
            PG8_WAIT_V(6); PG8_BAR; PG8_MMA(1, 1, At, B1); PG8_BAR;
            PG8_LDB(B0, 1, 0); PG8_SCHED; PG8_LDA(At, 1, 0); PG8_STAGE(PG8_SA(0, 1), a2 + hstep, voffA);
            PG8_WAIT_L(8); PG8_BAR; PG8_WAIT_L(0); PG8_MMA(0, 0, At, B0); PG8_BAR; PG8_SCHED;
            PG8_LDB(B1, 1, 1); PG8_STAGE(PG8_SB(1, 0), b3, voffB);
            PG8_BAR; PG8_WAIT_L(0); PG8_MMA(0, 1, At, B1); PG8_BAR;
            PG8_LDA(At, 1, 1); PG8_STAGE(PG8_SA(1, 0), a3, voffA);
            PG8_BAR; PG8_WAIT_L(0); PG8_MMA(1, 0, At, B0); PG8_BAR; PG8_SCHED;
            PG8_STAGE(PG8_SB(1, 1), b3 + hstep, voffB);
            PG8_WAIT_V(6); PG8_BAR; PG8_MMA(1, 1, At, B1); PG8_BAR;
        }
        E(acc, cur, wr, wc, fr, fq);
        if (!has_next) break;
#pragma unroll
        for (int a = 0; a < 2; ++a)
#pragma unroll
            for (int b = 0; b < 2; ++b)
#pragma unroll
                for (int m = 0; m < 4; ++m)
#pragma unroll
                    for (int n = 0; n < 2; ++n) acc[a][b][m][n] = (f32x4){0.f, 0.f, 0.f, 0.f};
        cur = nxt; cA = nA; cB = nB; ++ui;
    }
    PG8_WAIT_V(0);
    if (wr == 0) PG8_BAR;
    PG8_BAR;
#undef PG8_SA
#undef PG8_SB
#undef PG8_STAGE
#undef PG8_LDA
#undef PG8_LDB
#undef PG8_MMA
#undef PG8_WAIT_V
#undef PG8_WAIT_L
#undef PG8_BAR
#undef PG8_SCHED
}
}
using pg8::Unit;

struct EpiSwiglu {
    static constexpr bool PERM = true;
    bf16_t* H; const float* ssq; const float* shw;
    __device__ __forceinline__ void operator()(const f32x4 (&acc)[2][2][4][2], const Unit& u, int wr, int wc, int fr, int fq) const {
        const int row0 = u.pm * 256 + wr * 64 + fr, col0 = u.pn * 128 + wc * 32 + 8 * fq;
        const bool fused = ssq != nullptr;
        float rq[2][4]; f32x4 sg[2][2], su[2][2];
        if (fused) {
#pragma unroll
            for (int ai = 0; ai < 2; ++ai) {
                const int b = u.pm < 256 ? (u.pm >> 4) : 16 + (u.pm - 256) * 4 + ai * 2 + wr;
                const float* sp = shw + (size_t)b * (2 * DFF) + u.pn * 256 + wc * 32 + 8 * fq;
                sg[ai][0] = *(const f32x4*)sp; sg[ai][1] = *(const f32x4*)(sp + 4); su[ai][0] = *(const f32x4*)(sp + 128); su[ai][1] = *(const f32x4*)(sp + 132);
#pragma unroll
                for (int m = 0; m < 4; ++m) rq[ai][m] = ssq[row0 + ai * 128 + m * 16];
            }
        }
#pragma unroll
        for (int ai = 0; ai < 2; ++ai) {
#pragma unroll
            for (int m = 0; m < 4; ++m) {
                const int row = row0 + ai * 128 + m * 16;
                bf16_t* rowp = H + (size_t)row * DFF + col0;
                const float r = fused ? rsqrtf(rq[ai][m] * (1.0f / DM) + 1e-6f) : 1.0f;
                float v[8];
#pragma unroll
                for (int n = 0; n < 2; ++n)
#pragma unroll
                    for (int j = 0; j < 4; ++j) {
                        float g = acc[ai][0][m][n][j], uu = acc[ai][1][m][n][j];
                        if (fused) { g = g * r + sg[ai][n][j]; uu = uu * r + su[ai][n][j]; }
                        v[n * 4 + j] = fsilu(g) * uu;
                    }
                u32x4 w; w.x = cvt_pk_bf16(v[0], v[1]); w.y = cvt_pk_bf16(v[2], v[3]); w.z = cvt_pk_bf16(v[4], v[5]); w.w = cvt_pk_bf16(v[6], v[7]);
                *(u32x4*)rowp = w;
            }
        }
    }
};
struct EpiPlainF32 {
    static constexpr bool PERM = false;
    float* C; int ldc;
    __device__ __forceinline__ void operator()(const f32x4 (&acc)[2][2][4][2], const Unit& u, int wr, int wc, int fr, int fq) const {
        const int col0 = u.pn * 256 + wc * 32 + 4 * fq;
#pragma unroll
        for (int ai = 0; ai < 2; ++ai)
#pragma unroll
            for (int m = 0; m < 4; ++m) {
                float* op = C + (size_t)(u.pm * 256 + ai * 128 + wr * 64 + m * 16 + fr) * ldc + col0;
#pragma unroll
                for (int bj = 0; bj < 2; ++bj)
#pragma unroll
                    for (int n = 0; n < 2; ++n) *(f32x4*)(op + bj * 128 + n * 16) = acc[ai][bj][m][n];
            }
    }
};
template <int MODE, bool BASE16> struct EpiResid {
    static constexpr bool PERM = true;
    const float* xa; const float* xb; const bf16_t* xr; bf16_t* xo; const float* gate;
    bf16_t* an; const float* gn; const float* scn; float* ssq;
    float coef; int pad_;
    struct Row { f32x4 f[2][2]; u32x4 h[2]; };
    __device__ __forceinline__ void loadrow(Row& r, const Unit& u, int ai, int m, int wr, int fr, int col0) const {
        const int row = u.pm * 256 + ai * 128 + wr * 64 + m * 16 + fr;
        if (BASE16) {
#pragma unroll
            for (int bj = 0; bj < 2; ++bj) r.h[bj] = *(const u32x4*)(xr + (size_t)row * DM + col0 + bj * 128);
        } else {
            const float* bp = (row < TP ? xa + (size_t)row * DM : xb + (size_t)(row - TP) * DM) + col0;
#pragma unroll
            for (int bj = 0; bj < 2; ++bj)
#pragma unroll
                for (int n = 0; n < 2; ++n) r.f[bj][n] = *(const f32x4*)(bp + bj * 128 + n * 4);
        }
    }
    __device__ __forceinline__ void operator()(const f32x4 (&acc)[2][2][4][2], const Unit& u, int wr, int wc, int fr, int fq) const {
        const int col0 = u.pn * 256 + wc * 32 + 8 * fq;
        Row xbuf[2];
        loadrow(xbuf[0], u, 0, 0, wr, fr, col0);
        f32x4 gv[2][2], gs[2][2];
#pragma unroll
        for (int ai = 0; ai < 2; ++ai) {
            if (ai == 0 || u.pm >= 256) {
                const int b = u.pm < 256 ? (u.pm >> 4) : 16 + (u.pm - 256) * 4 + ai * 2 + wr;
                const float* gp = gate + (size_t)b * NMOD + col0;
#pragma unroll
                for (int bj = 0; bj < 2; ++bj)
#pragma unroll
                    for (int n = 0; n < 2; ++n) {
                        gv[bj][n] = *(const f32x4*)(gp + bj * 128 + n * 4) * coef;
                        if (MODE == 1) gs[bj][n] = *(const f32x4*)(gn + col0 + bj * 128 + n * 4) * (*(const f32x4*)(scn + (size_t)b * NMOD + col0 + bj * 128 + n * 4) + 1.0f);
                        if (MODE == 2) gs[bj][n] = *(const f32x4*)(gn + col0 + bj * 128 + n * 4);
                    }
            }
#pragma unroll
            for (int m = 0; m < 4; ++m) {
                const int cur = (ai * 4 + m) & 1;
                if (ai * 4 + m + 1 < 8) loadrow(xbuf[cur ^ 1], u, (ai * 4 + m + 1) >> 2, (ai * 4 + m + 1) & 3, wr, fr, col0);
                const int row = u.pm * 256 + ai * 128 + wr * 64 + m * 16 + fr;
                float sq = 0.f;
#pragma unroll
                for (int bj = 0; bj < 2; ++bj) {
                    u32x4 w, wx;
#pragma unroll
                    for (int n = 0; n < 2; ++n) {
                        f32x4 base;
                        if (BASE16) { const unsigned lo = n ? xbuf[cur].h[bj].z : xbuf[cur].h[bj].x, hi = n ? xbuf[cur].h[bj].w : xbuf[cur].h[bj].y; base = (f32x4){bf_lo(lo), bf_hi(lo), bf_lo(hi), bf_hi(hi)}; }
                        else base = xbuf[cur].f[bj][n];
                        const f32x4 x = base + gv[bj][n] * acc[ai][bj][m][n];
                        sq += x[0] * x[0] + x[1] * x[1] + x[2] * x[2] + x[3] * x[3];
                        const f32x4 y = x * gs[bj][n];
                        if (n == 0) { w.x = cvt_pk_bf16(y[0], y[1]); w.y = cvt_pk_bf16(y[2], y[3]); wx.x = cvt_pk_bf16(x[0], x[1]); wx.y = cvt_pk_bf16(x[2], x[3]); }
                        else { w.z = cvt_pk_bf16(y[0], y[1]); w.w = cvt_pk_bf16(y[2], y[3]); wx.z = cvt_pk_bf16(x[0], x[1]); wx.w = cvt_pk_bf16(x[2], x[3]); }
                    }
                    if (MODE == 1) *(u32x4*)(xo + (size_t)row * DM + col0 + bj * 128) = wx;
                    *(u32x4*)(an + (size_t)row * DM + col0 + bj * 128) = w;
                }
                sq += __shfl_xor(sq, 16); sq += __shfl_xor(sq, 32);
                if (fq == 0) __hip_atomic_fetch_add(ssq + row, sq, __ATOMIC_RELAXED, __HIP_MEMORY_SCOPE_AGENT);
            }
        }
    }
};
struct EpiInproj {
    static constexpr bool PERM = true;
    unsigned char* big; const float* lbl; float* out; const float* ssq; const float* shw;
    __device__ __forceinline__ void store8(bf16_t* p, const f32x4& a, const f32x4& b) const {
        u32x4 w; w.x = cvt_pk_bf16(a[0], a[1]); w.y = cvt_pk_bf16(a[2], a[3]); w.z = cvt_pk_bf16(b[0], b[1]); w.w = cvt_pk_bf16(b[2], b[3]); *(u32x4*)p = w;
    }
    __device__ __forceinline__ void operator()(const f32x4 (&acc_)[2][2][4][2], const Unit& u, int wr, int wc, int fr, int fq) const {
        const int row0 = u.pm * 256 + wr * 64 + fr, cw = wc * 32 + 8 * fq;
        const int pn = u.pn;
        f32x4 acc[2][2][4][2];
        float rq[2][4];
#pragma unroll
        for (int ai = 0; ai < 2; ++ai)
#pragma unroll
            for (int m = 0; m < 4; ++m) rq[ai][m] = ssq[row0 + ai * 128 + m * 16];
#pragma unroll
        for (int ai = 0; ai < 2; ++ai) {
            const int b = u.pm < 256 ? (u.pm >> 4) : 16 + (u.pm - 256) * 4 + ai * 2 + wr;
            const float* sp = shw + (size_t)b * DIN + pn * 256 + cw;
            f32x4 sh[2][2];
#pragma unroll
            for (int bj = 0; bj < 2; ++bj) { sh[bj][0] = *(const f32x4*)(sp + bj * 128); sh[bj][1] = *(const f32x4*)(sp + bj * 128 + 4); }
#pragma unroll
            for (int m = 0; m < 4; ++m) {
                const float r = rsqrtf(rq[ai][m] * (1.0f / DM) + 1e-6f);
#pragma unroll
                for (int bj = 0; bj < 2; ++bj)
#pragma unroll
                    for (int n = 0; n < 2; ++n) acc[ai][bj][m][n] = acc_[ai][bj][m][n] * r + sh[bj][n];
            }
        }
        if (pn == 2 || pn == 3) {
            bf16_t* zk = (bf16_t*)(big + Z_K); float* zg = (float*)(big + Z_G2);
#pragma unroll
            for (int bj = 0; bj < 2; ++bj) {
                const int cc = (pn - 2) * 256 + bj * 128 + cw;
                float lb[8];
#pragma unroll
                for (int j = 0; j < 8; ++j) lb[j] = 1.0f / (1.0f + __expf(lbl[512 + cc + j] - lbl[cc + j]));
#pragma unroll
                for (int ai = 0; ai < 2; ++ai)
#pragma unroll
                    for (int m = 0; m < 4; ++m) {
                        const size_t row = (size_t)(row0 + ai * 128 + m * 16);
                        f32x4 kk[2], gg[2];
#pragma unroll
                        for (int n = 0; n < 2; ++n)
#pragma unroll
                            for (int j = 0; j < 4; ++j) {
                                const float f = acc[ai][bj][m][n][j], l = lb[n * 4 + j];
                                const float e = __expf(-f), sg = __builtin_amdgcn_rcpf(1.0f + e);
                                const float forget = l + (1.0f - l) * sg;
                                kk[n][j] = (1.0f - l) * (1.0f - sg);
                                gg[n][j] = __logf(forget);
                            }
                        store8(zk + row * 512 + cc, kk[0], kk[1]);
                        *(f32x4*)(zg + row * 512 + cc) = gg[0]; *(f32x4*)(zg + row * 512 + cc + 4) = gg[1];
                    }
            }
        } else if (pn == 10) {
#pragma unroll
            for (int bj = 0; bj < 2; ++bj) {
                bf16_t* z = (bf16_t*)(big + (bj ? Z_SV : Z_SK));
#pragma unroll
                for (int ai = 0; ai < 2; ++ai) {
                    float* cp = nullptr;
                    if (u.pm < 256) { if ((u.pm & 15) == 15 && ai == 1) cp = out + (bj ? O_CVP : O_CKP) + (size_t)(u.pm >> 4) * 16384 + (size_t)(wr * 64) * 128; }
                    else cp = out + (bj ? O_CVS : O_CKS) + (size_t)((u.pm - 256) * 4 + ai * 2 + wr) * 16384 + (size_t)64 * 128;
#pragma unroll
                    for (int m = 0; m < 4; ++m) {
                        const size_t row = (size_t)(row0 + ai * 128 + m * 16);
                        store8(z + row * 128 + cw, acc[ai][bj][m][0], acc[ai][bj][m][1]);
                        if (cp) { float* q = cp + (size_t)(m * 16 + fr) * 128 + cw; *(f32x4*)q = acc[ai][bj][m][0]; *(f32x4*)(q + 4) = acc[ai][bj][m][1]; }
                    }
                }
            }
        } else {
            const bool isq = pn < 2 || pn == 6 || pn == 7;
            const size_t zoff = pn < 2 ? Z_Q : (pn < 6 ? Z_V : (pn < 8 ? Z_OG : Z_SQ));
            const int cbase = (pn & 1) * 256;
            bf16_t* z = (bf16_t*)(big + zoff);
#pragma unroll
            for (int bj = 0; bj < 2; ++bj)
#pragma unroll
                for (int ai = 0; ai < 2; ++ai)
#pragma unroll
                    for (int m = 0; m < 4; ++m) {
                        const size_t row = (size_t)(row0 + ai * 128 + m * 16);
                        f32x4 a = acc[ai][bj][m][0], b = acc[ai][bj][m][1];
                        if (isq) {
#pragma unroll
                            for (int j = 0; j < 4; ++j) { a[j] = fsilu(a[j]); b[j] = fsilu(b[j]); }
                        }
                        store8(z + row * 512 + cbase + bj * 128 + cw, a, b);
                    }
        }
    }
};

__device__ __forceinline__ void cvt_tile(const float* src, bf16_t* dst, int K, int N, int mode, int tile, int lane) {
    const int ntn = N >> 6, tk = tile / ntn, tn = tile - tk * ntn, k0 = tk * 64, n = tn * 64 + lane;
    int nd = n;
    if (mode == 1) { if (nd < DFF) nd = 256 * (nd >> 7) + (nd & 127); else { const int uu = nd - DFF; nd = 256 * (uu >> 7) + 128 + (uu & 127); } }
    const float* sp = src + (size_t)k0 * N + n;
    bf16_t* dp = dst + (size_t)nd * K + k0;
#pragma unroll
    for (int h = 0; h < 2; ++h) {
        float v[32];
#pragma unroll
        for (int j = 0; j < 32; ++j) v[j] = sp[(size_t)(h * 32 + j) * N];
#pragma unroll
        for (int q = 0; q < 4; ++q) {
            u32x4 w; w.x = cvt_pk_bf16(v[8 * q], v[8 * q + 1]); w.y = cvt_pk_bf16(v[8 * q + 2], v[8 * q + 3]); w.z = cvt_pk_bf16(v[8 * q + 4], v[8 * q + 5]); w.w = cvt_pk_bf16(v[8 * q + 6], v[8 * q + 7]);
            *(u32x4*)(dp + h * 32 + q * 8) = w;
        }
    }
}

__device__ __forceinline__ void adaln_strip(const Params& p, int strip, LAS unsigned char* lds) {
    LAS float* sc = (LAS float*)lds;
    const int tid = threadIdx.x, lane = tid & 63, c2 = (lane & 31) * 2, kg = (tid >> 6) * 2 + (lane >> 5);
    float acc0[NB], acc1[NB];
#pragma unroll
    for (int b = 0; b < NB; ++b) { acc0[b] = 0.f; acc1[b] = 0.f; }
    for (int ch = 0; ch < 4; ++ch) {
        __syncthreads();
        for (int e = tid; e < NB * 256; e += 512) {
            const int b = e >> 8, kk = e & 255;
            const float c = b < 16 ? p.c_p[b * DM + ch * 256 + kk] : p.c_s[(b - 16) * DM + ch * 256 + kk];
            sc[kk * NB + b] = c / (1.0f + expf(-c));
        }
        __syncthreads();
        f32x2 wv[16];
#pragma unroll
        for (int kk = 0; kk < 16; ++kk) wv[kk] = *(const f32x2*)(p.w_ada + (size_t)(ch * 256 + kg * 16 + kk) * NMOD + strip * 64 + c2);
#pragma unroll
        for (int kk = 0; kk < 16; ++kk) {
            const LAS f32x4* s4 = (const LAS f32x4*)(sc + (kg * 16 + kk) * NB);
#pragma unroll
            for (int b4 = 0; b4 < NB / 4; ++b4) {
                const f32x4 s = s4[b4];
#pragma unroll
                for (int j = 0; j < 4; ++j) { acc0[4 * b4 + j] += s[j] * wv[kk].x; acc1[4 * b4 + j] += s[j] * wv[kk].y; }
            }
        }
    }
    __syncthreads();
    LAS float* red = (LAS float*)lds;
#pragma unroll
    for (int b = 0; b < NB; ++b) {
        const float a0 = acc0[b] + __shfl_xor(acc0[b], 32), a1 = acc1[b] + __shfl_xor(acc1[b], 32);
        if (lane < 32) { red[((tid >> 6) * NB + b) * 64 + c2] = a0; red[((tid >> 6) * NB + b) * 64 + c2 + 1] = a1; }
    }
    __syncthreads();
    float* mod = (float*)(p.ws + W_MOD);
    for (int e = tid; e < NB * 64; e += 512) {
        const int b = e >> 6, c = e & 63;
        float s = 0.f;
#pragma unroll
        for (int g = 0; g < 8; ++g) s += red[(g * NB + b) * 64 + c];
        mod[(size_t)b * NMOD + strip * 64 + c] = s + p.b_ada[strip * 64 + c];
    }
    __syncthreads();
}

__device__ __forceinline__ void phase0(const Params& p, LAS unsigned char* lds) {
    if (blockIdx.x < 144) adaln_strip(p, blockIdx.x, lds);
    {
        const size_t n4 = (size_t)32 * 64 * 128 / 4;
        for (size_t i = (size_t)blockIdx.x * 512 + threadIdx.x; i < 2 * n4; i += (size_t)gridDim.x * 512) {
            const int which = i >= n4; const size_t j = which ? i - n4 : i;
            const size_t sb = j / 2048, r = j % 2048;
            const f32x4 v = *(const f32x4*)((which ? p.cache_v : p.cache_k) + sb * 16384 + 8192 + r * 4);
            *(f32x4*)(p.out + (which ? O_CVS : O_CKS) + sb * 16384 + r * 4) = v;
        }
    }
    for (int i = blockIdx.x * 512 + threadIdx.x; i < 16384; i += gridDim.x * 512) ((float*)(p.ws + W_ZERO))[i] = 0.f;
    for (int i = blockIdx.x * 512 + threadIdx.x; i < 3 * T; i += gridDim.x * 512) ((float*)(p.ws + W_SSQ))[i] = 0.f;
    if (blockIdx.x < 144 && gridDim.x > 160) return;
    const int wid = threadIdx.x >> 6, lane = threadIdx.x & 63;
    const int cb = gridDim.x > 160 ? (int)blockIdx.x - 144 : (int)blockIdx.x, ncb = gridDim.x > 160 ? (int)gridDim.x - 144 : (int)gridDim.x;
    for (int t = cb * 8 + wid; t < 5184; t += ncb * 8) {
        if (t < 1408) cvt_tile(p.w_up1, (bf16_t*)(p.ws + W_UP1), DM, 2 * DFF, 1, t, lane);
        else if (t < 2112) cvt_tile(p.w_down1, (bf16_t*)(p.ws + W_DN1), DFF, DM, 0, t - 1408, lane);
        else if (t < 2816) cvt_tile(p.w_in, (bf16_t*)(p.ws + W_IN), DM, DIN, 0, t - 2112, lane);
        else if (t < 3072) cvt_tile(p.w_out, (bf16_t*)(p.ws + W_OUT), DM, DM, 0, t - 2816, lane);
        else if (t < 4480) cvt_tile(p.w_up2, (bf16_t*)(p.ws + W_UP2), DM, 2 * DFF, 1, t - 3072, lane);
        else cvt_tile(p.w_down2, (bf16_t*)(p.ws + W_DN2), DFF, DM, 0, t - 4480, lane);
    }
}

__device__ __forceinline__ float wave_sum(float v) {
#pragma unroll
    for (int o = 32; o > 0; o >>= 1) v += __shfl_xor(v, o);
    return v;
}
__device__ __forceinline__ void norm_mod_row(const f32x4 (&v)[4], const float* gvec, const float* mrow, int shift_idx, int scale_idx, bf16_t* hrow, int lane) {
    float ss = 0.f;
#pragma unroll
    for (int i = 0; i < 4; ++i) ss += v[i][0] * v[i][0] + v[i][1] * v[i][1] + v[i][2] * v[i][2] + v[i][3] * v[i][3];
    ss = wave_sum(ss);
    const float rstd = rsqrtf(ss * (1.0f / DM) + 1e-6f);
#pragma unroll
    for (int i = 0; i < 2; ++i) {
        const int c0 = i * 512 + lane * 8;
        float y[8];
#pragma unroll
        for (int q = 0; q < 2; ++q) {
            const f32x4 g = *(const f32x4*)(gvec + c0 + 4 * q), sc = *(const f32x4*)(mrow + scale_idx * DM + c0 + 4 * q), sh = *(const f32x4*)(mrow + shift_idx * DM + c0 + 4 * q);
#pragma unroll
            for (int j = 0; j < 4; ++j) y[4 * q + j] = v[2 * i + q][j] * rstd * g[j] * (1.0f + sc[j]) + sh[j];
        }
        u32x4 w; w.x = cvt_pk_bf16(y[0], y[1]); w.y = cvt_pk_bf16(y[2], y[3]); w.z = cvt_pk_bf16(y[4], y[5]); w.w = cvt_pk_bf16(y[6], y[7]);
        *(u32x4*)(hrow + c0) = w;
    }
}
__device__ __forceinline__ void norm_mod_phase(const float* xa, const float* xb, const float* gvec, const float* mod, int shift_idx, int scale_idx, bf16_t* h) {
    const int wid = threadIdx.x >> 6, lane = threadIdx.x & 63, stride = gridDim.x * 8;
    for (int row = blockIdx.x * 8 + wid; row < T; row += 4 * stride) {
        int rr[4]; bool ok[4]; f32x4 v[4][4];
#pragma unroll
        for (int q = 0; q < 4; ++q) {
            ok[q] = row + q * stride < T; rr[q] = ok[q] ? row + q * stride : row;
            const float* sp = rr[q] < TP ? xa + (size_t)rr[q] * DM : xb + (size_t)(rr[q] - TP) * DM;
#pragma unroll
            for (int i = 0; i < 2; ++i) { v[q][2 * i] = *(const f32x4*)(sp + i * 512 + lane * 8); v[q][2 * i + 1] = *(const f32x4*)(sp + i * 512 + lane * 8 + 4); }
        }
#pragma unroll
        for (int q = 0; q < 4; ++q)
            if (ok[q]) norm_mod_row(v[q], gvec, mod + (size_t)batch_of_row(rr[q]) * NMOD, shift_idx, scale_idx, h + (size_t)rr[q] * DM, lane);
    }
}
template <int PART> __device__ __forceinline__ void final_norm_phase(float* y, const bf16_t* a, const float* ssq, int blk, int nblk) {
    const int wid = threadIdx.x >> 6, lane = threadIdx.x & 63, stride = nblk * 8;
    constexpr int R = PART == 0 ? TP - 1024 : 1024 + TS;
    for (int idx = blk * 8 + wid; idx < R; idx += 4 * stride) {
        int rr[4]; bool ok[4]; u32x4 v[4][2]; float sq[4];
#pragma unroll
        for (int q = 0; q < 4; ++q) {
            ok[q] = idx + q * stride < R; const int ix = ok[q] ? idx + q * stride : idx;
            rr[q] = PART == 0 ? (ix < 32768 ? ix : ix + 1024) : (ix < 1024 ? 32768 + ix : TP + ix - 1024);
            const bf16_t* sp = a + (size_t)rr[q] * DM;
            v[q][0] = *(const u32x4*)(sp + lane * 8); v[q][1] = *(const u32x4*)(sp + 512 + lane * 8);
            sq[q] = ssq[rr[q]];
        }
#pragma unroll
        for (int q = 0; q < 4; ++q) {
            const float r = rsqrtf(sq[q] * (1.0f / DM) + 1e-6f);
            if (ok[q]) {
                float* dp = y + (size_t)rr[q] * DM;
#pragma unroll
                for (int i = 0; i < 2; ++i) {
                    const u32x4 w = v[q][i];
                    *(f32x4*)(dp + i * 512 + lane * 8) = (f32x4){bf_lo(w.x) * r, bf_hi(w.x) * r, bf_lo(w.y) * r, bf_hi(w.y) * r};
                    *(f32x4*)(dp + i * 512 + lane * 8 + 4) = (f32x4){bf_lo(w.z) * r, bf_hi(w.z) * r, bf_lo(w.w) * r, bf_hi(w.w) * r};
                }
            }
        }
    }
}

constexpr int HG_QS = 0, HG_KS = 17408, HG_KT = 34816, HG_VT = 53248, HG_AS = 71680, HG_ST = 80896, HG_DEC = 115712, HG_TOT = 116224  , HG_SSQ = 120320;
__device__ __forceinline__ f32x4 mfma16(bf16x8 a, bf16x8 b, f32x4 c) { return __builtin_amdgcn_mfma_f32_16x16x32_bf16(a, b, c, 0, 0, 0); }

__device__ __forceinline__ void hgrn_unit(const Params& p, int row0, int nc, int h, const float* S0, float* Sout, int mode, float* Dout, LAS unsigned char* lds) {
    unsigned char* big = p.ws + W_BIG;
    bf16_t* zq = (bf16_t*)(big + Z_Q); const bf16_t* zk = (const bf16_t*)(big + Z_K); const bf16_t* zv = (const bf16_t*)(big + Z_V);
    const bf16_t* zog = (const bf16_t*)(big + Z_OG); float* zg = (float*)(big + Z_G2);
    bf16_t* ymix = (bf16_t*)(p.ws + W_H);
    LAS bf16_t* Qs = (LAS bf16_t*)(lds + HG_QS); LAS bf16_t* Ks = (LAS bf16_t*)(lds + HG_KS); LAS bf16_t* Kt = (LAS bf16_t*)(lds + HG_KT);
    LAS bf16_t* Vt = (LAS bf16_t*)(lds + HG_VT); LAS bf16_t* As = (LAS bf16_t*)(lds + HG_AS); LAS bf16_t* St = (LAS bf16_t*)(lds + HG_ST);
    LAS float* dec = (LAS float*)(lds + HG_DEC); LAS float* tot = (LAS float*)(lds + HG_TOT); LAS float* ssq = (LAS float*)(lds + HG_SSQ);
    const int tid = threadIdx.x, wid = __builtin_amdgcn_readfirstlane(tid >> 6), lane = tid & 63, fr = lane & 15, fq = lane >> 4;
    const int tg = wid, c2 = 2 * lane;
    const int ttile = wid & 3, half = wid >> 2;
    const int vs = lane, v8 = wid;
    const unsigned lo_e = (unsigned)lane * 2u, lo_v = (unsigned)lane * 512u;

    __syncthreads();
    f32x4 Sacc[8];
#pragma unroll
    for (int vt = 0; vt < 8; ++vt) {
        {
            const float* sp = S0 + (size_t)(16 * wid) * 128 + 16 * vt;
            const unsigned so = (unsigned)fq * 512u + fr;
            Sacc[vt] = (f32x4){sp[so], sp[so + 128], sp[so + 256], sp[so + 384]};
        }
        u32x2 w; w.x = cvt_pk_bf16(Sacc[vt][0], Sacc[vt][1]); w.y = cvt_pk_bf16(Sacc[vt][2], Sacc[vt][3]);
        *(LAS u32x2*)(St + (16 * vt + fr) * 136 + 16 * wid + 4 * fq) = w;
    }
    f32x2 gg[8]; unsigned qq[8], kk[8]; u32x4 vv[2];
    {
        const size_t ub = ((size_t)row0 + 8 * tg) * 512 + h * 128;
        const float* gp = zg + ub; const bf16_t* qp = zq + ub; const bf16_t* kp = zk + ub;
#pragma unroll
        for (int i = 0; i < 8; ++i) { gg[i] = *(const f32x2*)(gp + i * 512 + lo_e); qq[i] = *(const unsigned*)(qp + i * 512 + lo_e); kk[i] = *(const unsigned*)(kp + i * 512 + lo_e); }
        const bf16_t* vp = zv + (size_t)row0 * 512 + h * 128 + v8 * 8;
#pragma unroll
        for (int i = 0; i < 2; ++i) vv[i] = *(const u32x4*)(vp + i * 64 + lo_v);
    }
    f32x2 ecum = {1.0f, 1.0f};
    for (int c = 0; c < nc; ++c) {
        const size_t rowc = (size_t)row0 + (size_t)c * 64;
#pragma unroll
        for (int i = 1; i < 8; ++i) gg[i] += gg[i - 1];
        *(LAS f32x2*)(tot + tg * 128 + c2) = gg[7];
        __syncthreads();
        {
            f32x2 off = {0.f, 0.f}, blast = {0.f, 0.f};
#pragma unroll
            for (int j = 0; j < 8; ++j) { const f32x2 t = *(const LAS f32x2*)(tot + j * 128 + c2); blast += t; if (j < tg) off += t; }
            const f32x2 edec = {__expf(blast.x), __expf(blast.y)};
            if (tg == 0) *(LAS f32x2*)(dec + c2) = edec;
            unsigned kt0[4], kt1[4];
#pragma unroll
            for (int i = 0; i < 8; i += 2) {
                float ka[2], kb[2];
#pragma unroll
                for (int j = 0; j < 2; ++j) {
                    const f32x2 bb = off + gg[i + j];
                    const float eb0 = __expf(bb.x), ei0 = __expf(-bb.x), eb1 = __expf(bb.y), ei1 = __expf(-bb.y);
                    const float q0 = bf_lo(qq[i + j]) * eb0, q1 = bf_hi(qq[i + j]) * eb1, k0 = bf_lo(kk[i + j]) * ei0, k1 = bf_hi(kk[i + j]) * ei1;
                    ka[j] = k0 * edec.x; kb[j] = k1 * edec.y;
                    const int s = 8 * tg + i + j;
                    *(LAS unsigned*)(Qs + s * 136 + c2) = cvt_pk_bf16(q0, q1);
                    *(LAS unsigned*)(Ks + s * 136 + c2) = cvt_pk_bf16(k0, k1);
                    if (mode) *(unsigned*)((zq + (rowc + 8 * tg) * 512 + h * 128) + (i + j) * 512 + lo_e) = cvt_pk_bf16(q0 * ecum.x, q1 * ecum.y);
                }
                kt0[i >> 1] = cvt_pk_bf16(ka[0], ka[1]); kt1[i >> 1] = cvt_pk_bf16(kb[0], kb[1]);
            }
            ecum *= edec;
            *(LAS u32x4*)(Kt + c2 * 72 + 8 * tg) = (u32x4){kt0[0], kt0[1], kt0[2], kt0[3]};
            *(LAS u32x4*)(Kt + (c2 + 1) * 72 + 8 * tg) = (u32x4){kt1[0], kt1[1], kt1[2], kt1[3]};
#pragma unroll
            for (int i = 0; i < 2; ++i) {
                const int vb = (v8 + 8 * i) * 8;
#pragma unroll
                for (int j = 0; j < 4; ++j) { const unsigned w = vv[i][j]; Vt[(vb + 2 * j) * 72 + vs] = (bf16_t)(w & 0xffffu); Vt[(vb + 2 * j + 1) * 72 + vs] = (bf16_t)(w >> 16); }
            }
        }
        {
            const size_t rown = (size_t)row0 + (size_t)(c + 1 < nc ? c + 1 : c) * 64;
            const size_t ub = (rown + 8 * tg) * 512 + h * 128;
            const float* gp = zg + ub; const bf16_t* qp = zq + ub; const bf16_t* kp = zk + ub;
#pragma unroll
            for (int i = 0; i < 8; ++i) { gg[i] = *(const f32x2*)(gp + i * 512 + lo_e); qq[i] = *(const unsigned*)(qp + i * 512 + lo_e); kk[i] = *(const unsigned*)(kp + i * 512 + lo_e); }
            const bf16_t* vp = zv + rown * 512 + h * 128 + v8 * 8;
#pragma unroll
            for (int i = 0; i < 2; ++i) vv[i] = *(const u32x4*)(vp + i * 64 + lo_v);
        }
        u32x2 og[4];
        const int trow = 16 * ttile + fr;
        {
            const bf16_t* ogp = zog + (rowc + 16 * ttile) * 512 + h * 128 + 64 * half;
            const unsigned lo_o = (unsigned)fr * 512u + 4u * fq;
#pragma unroll
            for (int i = 0; i < 4; ++i) og[i] = mode ? (u32x2){0u, 0u} : *(const u32x2*)(ogp + 16 * i + lo_o);
        }
        __syncthreads();
        bf16x8 Qf[4];
#pragma unroll
        for (int k4 = 0; k4 < 4; ++k4) Qf[k4] = *(const LAS bf16x8*)(Qs + trow * 136 + 32 * k4 + 8 * fq);
#pragma unroll
        for (int si = 0; si < 2; ++si) {
            const int st = 2 * half + si;
            f32x4 a = (f32x4){0.f, 0.f, 0.f, 0.f};
            if (st <= ttile) {
#pragma unroll
                for (int k4 = 0; k4 < 4; ++k4) { const bf16x8 Kf = *(const LAS bf16x8*)(Ks + (16 * st + fr) * 136 + 32 * k4 + 8 * fq); a = mfma16(Kf, Qf[k4], a); }
#pragma unroll
                for (int r = 0; r < 4; ++r) a[r] = (16 * st + 4 * fq + r <= trow) ? a[r] : 0.f;
            }
            u32x2 w; w.x = cvt_pk_bf16(a[0], a[1]); w.y = cvt_pk_bf16(a[2], a[3]);
            *(LAS u32x2*)(As + trow * 72 + 16 * st + 4 * fq) = w;
        }
        __syncthreads();
        f32x4 Oacc[4];
        {
            bf16x8 Af[2];
#pragma unroll
            for (int k2 = 0; k2 < 2; ++k2) Af[k2] = *(const LAS bf16x8*)(As + trow * 72 + 32 * k2 + 8 * fq);
            float sq = 0.f;
#pragma unroll
            for (int i = 0; i < 4; ++i) {
                const int vrow = 16 * (4 * half + i) + fr;
                f32x4 a = (f32x4){0.f, 0.f, 0.f, 0.f};
#pragma unroll
                for (int k2 = 0; k2 < 2; ++k2) { const bf16x8 Vf = *(const LAS bf16x8*)(Vt + vrow * 72 + 32 * k2 + 8 * fq); a = mfma16(Vf, Af[k2], a); }
#pragma unroll
                for (int k4 = 0; k4 < 4; ++k4) { const bf16x8 Sf = *(const LAS bf16x8*)(St + vrow * 136 + 32 * k4 + 8 * fq); a = mfma16(Sf, Qf[k4], a); }
                Oacc[i] = a;
                sq += a[0] * a[0] + a[1] * a[1] + a[2] * a[2] + a[3] * a[3];
            }
            sq += __shfl_xor(sq, 16); sq += __shfl_xor(sq, 32);
            if (fq == 0) ssq[trow * 2 + half] = sq;
            const f32x4 dk = *(const LAS f32x4*)(dec + 16 * wid + 4 * fq);
            bf16x8 Ktf[2];
#pragma unroll
            for (int k2 = 0; k2 < 2; ++k2) Ktf[k2] = *(const LAS bf16x8*)(Kt + (16 * wid + fr) * 72 + 32 * k2 + 8 * fq);
#pragma unroll
            for (int vt = 0; vt < 8; ++vt) {
                f32x4 s = Sacc[vt] * dk;
#pragma unroll
                for (int k2 = 0; k2 < 2; ++k2) { const bf16x8 Vf = *(const LAS bf16x8*)(Vt + (16 * vt + fr) * 72 + 32 * k2 + 8 * fq); s = mfma16(Ktf[k2], Vf, s); }
                Sacc[vt] = s;
            }
        }
        __syncthreads();
#pragma unroll
        for (int vt = 0; vt < 8; ++vt) {
            u32x2 w; w.x = cvt_pk_bf16(Sacc[vt][0], Sacc[vt][1]); w.y = cvt_pk_bf16(Sacc[vt][2], Sacc[vt][3]);
            *(LAS u32x2*)(St + (16 * vt + fr) * 136 + 16 * wid + 4 * fq) = w;
        }
        if (mode == 0) {
            const float tots = ssq[trow * 2] + ssq[trow * 2 + 1];
            const float r = rsqrtf(tots * (1.0f / 128.0f) + 1e-6f);
#pragma unroll
            for (int i = 0; i < 4; ++i) {
                const f32x4 gn = *(const f32x4*)(p.g_hgrn + 16 * (4 * half + i) + 4 * fq);
                const float o0 = Oacc[i][0] * r * gn[0] * bf_lo(og[i].x), o1 = Oacc[i][1] * r * gn[1] * bf_hi(og[i].x);
                const float o2 = Oacc[i][2] * r * gn[2] * bf_lo(og[i].y), o3 = Oacc[i][3] * r * gn[3] * bf_hi(og[i].y);
                u32x2 w; w.x = cvt_pk_bf16(o0, o1); w.y = cvt_pk_bf16(o2, o3);
                *(u32x2*)(ymix + (rowc + 16 * ttile) * DM + h * 128 + 64 * half + 16 * i + ((unsigned)fr * 1024u + 4u * fq)) = w;
            }
        } else {
#pragma unroll
            for (int i = 0; i < 4; ++i) *(f32x4*)(zg + (rowc + 16 * ttile) * 512 + h * 128 + 64 * half + 16 * i + ((unsigned)fr * 512u + 4u * fq)) = Oacc[i];
        }
    }
#pragma unroll
    for (int vt = 0; vt < 8; ++vt)
#pragma unroll
        for (int r = 0; r < 4; ++r) Sout[(size_t)(16 * wid + 4 * fq + r) * 128 + 16 * vt + fr] = Sacc[vt][r];
    if (Dout && tg == 0) *(f32x2*)(Dout + c2) = ecum;
    __syncthreads();
}

__device__ __forceinline__ void hgrn_fix_unit(const Params& p, int bh, int seg, LAS unsigned char* lds) {
    const unsigned char* big = p.ws + W_BIG;
    const bf16_t* zq = (const bf16_t*)(big + Z_Q); const bf16_t* zog = (const bf16_t*)(big + Z_OG); const float* zg = (const float*)(big + Z_G2);
    const float* sseg = (const float*)(p.ws + W_SSEG) + (size_t)bh * 4 * 16384; const float* dseg = (const float*)(p.ws + W_DSEG) + (size_t)bh * 4 * 128;
    bf16_t* ymix = (bf16_t*)(p.ws + W_H);
    LAS bf16_t* St = (LAS bf16_t*)(lds + HG_ST); LAS float* ssq = (LAS float*)(lds + HG_SSQ);
    const int tid = threadIdx.x, wid = __builtin_amdgcn_readfirstlane(tid >> 6), lane = tid & 63, fr = lane & 15, fq = lane >> 4;
    const int ttile = wid & 3, half = wid >> 2, trow = 16 * ttile + fr, h = bh & 3;
    const size_t row0 = (size_t)(bh >> 2) * 4096 + (size_t)seg * 1024;
    __syncthreads();
    {
        f32x4 S[8];
        const unsigned so = (unsigned)fq * 512u + fr;
#pragma unroll
        for (int vt = 0; vt < 8; ++vt) { const float* sp = sseg + (size_t)(16 * wid) * 128 + 16 * vt; S[vt] = (f32x4){sp[so], sp[so + 128], sp[so + 256], sp[so + 384]}; }
        for (int j = 1; j <= seg; ++j) {
            if (j == seg && seg != 3) break;
            const f32x4 d = *(const f32x4*)(dseg + j * 128 + 16 * wid + 4 * fq);
            if (j == seg) {
                float* so_ = p.out + O_STP + (size_t)bh * 16384;
                f32x4 fin[8];
#pragma unroll
                for (int vt = 0; vt < 8; ++vt) { const float* sp = sseg + (size_t)j * 16384 + (size_t)(16 * wid) * 128 + 16 * vt; fin[vt] = (f32x4){sp[so], sp[so + 128], sp[so + 256], sp[so + 384]}; }
#pragma unroll
                for (int vt = 0; vt < 8; ++vt) { float* op = so_ + (size_t)(16 * wid) * 128 + 16 * vt;
                    op[so] = d[0] * S[vt][0] + fin[vt][0]; op[so + 128] = d[1] * S[vt][1] + fin[vt][1]; op[so + 256] = d[2] * S[vt][2] + fin[vt][2]; op[so + 384] = d[3] * S[vt][3] + fin[vt][3]; }
            } else {
#pragma unroll
                for (int vt = 0; vt < 8; ++vt) { const float* sp = sseg + (size_t)j * 16384 + (size_t)(16 * wid) * 128 + 16 * vt;
                    S[vt] = (f32x4){d[0] * S[vt][0] + sp[so], d[1] * S[vt][1] + sp[so + 128], d[2] * S[vt][2] + sp[so + 256], d[3] * S[vt][3] + sp[so + 384]}; }
            }
        }
#pragma unroll
        for (int vt = 0; vt < 8; ++vt) { u32x2 w; w.x = cvt_pk_bf16(S[vt][0], S[vt][1]); w.y = cvt_pk_bf16(S[vt][2], S[vt][3]); *(LAS u32x2*)(St + (16 * vt + fr) * 136 + 16 * wid + 4 * fq) = w; }
    }
    __syncthreads();
    bf16x8 Sf[4][4];
#pragma unroll
    for (int i = 0; i < 4; ++i)
#pragma unroll
        for (int k4 = 0; k4 < 4; ++k4) Sf[i][k4] = *(const LAS bf16x8*)(St + (16 * (4 * half + i) + fr) * 136 + 32 * k4 + 8 * fq);
    f32x4 gn[4];
#pragma unroll
    for (int i = 0; i < 4; ++i) gn[i] = *(const f32x4*)(p.g_hgrn + 16 * (4 * half + i) + 4 * fq);
    const unsigned lo_q = (unsigned)fr * 512u + 8u * fq, lo_o = (unsigned)fr * 512u + 4u * fq;
    bf16x8 Qf[4]; f32x4 acc[4]; u32x2 og[4];
    {
        const size_t rowt = row0 + 16 * ttile;
#pragma unroll
        for (int k4 = 0; k4 < 4; ++k4) Qf[k4] = *(const bf16x8*)(zq + rowt * 512 + h * 128 + 32 * k4 + lo_q);
#pragma unroll
        for (int i = 0; i < 4; ++i) { acc[i] = *(const f32x4*)(zg + rowt * 512 + h * 128 + 64 * half + 16 * i + lo_o); og[i] = *(const u32x2*)(zog + rowt * 512 + h * 128 + 64 * half + 16 * i + lo_o); }
    }
    for (int c = 0; c < 16; ++c) {
        const size_t rowt = row0 + (size_t)c * 64 + 16 * ttile;
        bf16x8 Qn[4]; f32x4 an[4]; u32x2 ogn[4];
        {
            const size_t rown = row0 + (size_t)(c < 15 ? c + 1 : c) * 64 + 16 * ttile;
#pragma unroll
            for (int k4 = 0; k4 < 4; ++k4) Qn[k4] = *(const bf16x8*)(zq + rown * 512 + h * 128 + 32 * k4 + lo_q);
#pragma unroll
            for (int i = 0; i < 4; ++i) { an[i] = *(const f32x4*)(zg + rown * 512 + h * 128 + 64 * half + 16 * i + lo_o); ogn[i] = *(const u32x2*)(zog + rown * 512 + h * 128 + 64 * half + 16 * i + lo_o); }
        }
        float sq = 0.f;
#pragma unroll
        for (int i = 0; i < 4; ++i) {
#pragma unroll
            for (int k4 = 0; k4 < 4; ++k4) acc[i] = mfma16(Sf[i][k4], Qf[k4], acc[i]);
            sq += acc[i][0] * acc[i][0] + acc[i][1] * acc[i][1] + acc[i][2] * acc[i][2] + acc[i][3] * acc[i][3];
        }
        sq += __shfl_xor(sq, 16); sq += __shfl_xor(sq, 32);
        LAS float* sp = ssq + (c & 1) * 128;
        if (fq == 0) sp[trow * 2 + half] = sq;
        __syncthreads();
        const float r = rsqrtf((sp[trow * 2] + sp[trow * 2 + 1]) * (1.0f / 128.0f) + 1e-6f);
#pragma unroll
        for (int i = 0; i < 4; ++i) {
            const float o0 = acc[i][0] * r * gn[i][0] * bf_lo(og[i].x), o1 = acc[i][1] * r * gn[i][1] * bf_hi(og[i].x);
            const float o2 = acc[i][2] * r * gn[i][2] * bf_lo(og[i].y), o3 = acc[i][3] * r * gn[i][3] * bf_hi(og[i].y);
            u32x2 w; w.x = cvt_pk_bf16(o0, o1); w.y = cvt_pk_bf16(o2, o3);
            *(u32x2*)(ymix + rowt * DM + h * 128 + 64 * half + 16 * i + ((unsigned)fr * 1024u + 4u * fq)) = w;
        }
#pragma unroll
        for (int i = 0; i < 4; ++i) { Qf[i] = Qn[i]; acc[i] = an[i]; og[i] = ogn[i]; }
    }
    __syncthreads();
}

constexpr int AT_KS = 0, AT_VT = 27648;
__device__ __forceinline__ void attn_unit(const Params& p, int a, LAS unsigned char* lds) {
    const unsigned char* big = p.ws + W_BIG;
    const bf16_t* zsq = (const bf16_t*)(big + Z_SQ); const bf16_t* zsk = (const bf16_t*)(big + Z_SK); const bf16_t* zsv = (const bf16_t*)(big + Z_SV);
    bf16_t* ymix = (bf16_t*)(p.ws + W_H);
    LAS bf16_t* Ks = (LAS bf16_t*)(lds + AT_KS); LAS bf16_t* Vt = (LAS bf16_t*)(lds + AT_VT);
    const int tid = threadIdx.x, wid = tid >> 6, lane = tid & 63, fr = lane & 15, fq = lane >> 4;
    int kvh, jb0; size_t row0; bool sample; int sb = 0, bb = 0, cc = 0;
    if (a < 2048) { bb = a >> 7; cc = (a >> 1) & 63; kvh = a & 1; row0 = (size_t)bb * 4096 + (size_t)cc * 64; jb0 = cc >= 2 ? 0 : 2 - cc; sample = false; }
    else { const int s2 = a - 2048; sb = s2 >> 1; kvh = s2 & 1; row0 = (size_t)TP + (size_t)sb * 64; jb0 = 0; sample = true; }
    const int ks = tid >> 3, kd8 = tid & 7;
    const int vsx = tid & 63, vd8 = tid >> 6;
    u32x4 kw[3], vw[3];
#pragma unroll
    for (int jb = 0; jb < 3; ++jb) {
        const size_t kr = (!sample && jb >= jb0) ? row0 - 128 + (size_t)jb * 64 : row0;
        kw[jb] = *(const u32x4*)(zsk + (kr + ks) * 128 + kvh * 64 + kd8 * 8);
        vw[jb] = *(const u32x4*)(zsv + (kr + vsx) * 128 + kvh * 64 + vd8 * 8);
    }
    const bf16_t* qbase = zsq + (row0 + 16 * (wid & 3) + fr) * 512 + (kvh * 4 + (wid >> 2)) * 64 + 8 * fq;
    bf16x8 Qf[2];
#pragma unroll
    for (int kd = 0; kd < 2; ++kd) Qf[kd] = *(const bf16x8*)(qbase + 32 * kd);
    __syncthreads();
    if (!sample) {
#pragma unroll
        for (int jb = 0; jb < 3; ++jb) {
            if (jb >= jb0) {
                *(LAS u32x4*)(Ks + (jb * 64 + ks) * 72 + kd8 * 8) = kw[jb];
#pragma unroll
                for (int j = 0; j < 4; ++j) { const unsigned w = vw[jb][j]; Vt[(vd8 * 8 + 2 * j) * 200 + jb * 64 + vsx] = (bf16_t)(w & 0xffffu); Vt[(vd8 * 8 + 2 * j + 1) * 200 + jb * 64 + vsx] = (bf16_t)(w >> 16); }
            }
        }
    } else {
#pragma unroll 1
        for (int jb = 0; jb < 3; ++jb) {
            u32x4 kq, vq;
            if (jb < 2) {
                const float* kp = p.cache_k + ((size_t)(sb * 128 + jb * 64 + ks) * 2 + kvh) * 64 + kd8 * 8;
                const float* vp = p.cache_v + ((size_t)(sb * 128 + jb * 64 + vsx) * 2 + kvh) * 64 + vd8 * 8;
                const f32x4 k0 = *(const f32x4*)kp, k1 = *(const f32x4*)(kp + 4), v0 = *(const f32x4*)vp, v1 = *(const f32x4*)(vp + 4);
                kq = (u32x4){cvt_pk_bf16(k0[0], k0[1]), cvt_pk_bf16(k0[2], k0[3]), cvt_pk_bf16(k1[0], k1[1]), cvt_pk_bf16(k1[2], k1[3])};
                vq = (u32x4){cvt_pk_bf16(v0[0], v0[1]), cvt_pk_bf16(v0[2], v0[3]), cvt_pk_bf16(v1[0], v1[1]), cvt_pk_bf16(v1[2], v1[3])};
            } else {
                kq = *(const u32x4*)(zsk + (row0 + ks) * 128 + kvh * 64 + kd8 * 8);
                vq = *(const u32x4*)(zsv + (row0 + vsx) * 128 + kvh * 64 + vd8 * 8);
            }
            *(LAS u32x4*)(Ks + (jb * 64 + ks) * 72 + kd8 * 8) = kq;
#pragma unroll
            for (int j = 0; j < 4; ++j) { const unsigned w = vq[j]; Vt[(vd8 * 8 + 2 * j) * 200 + jb * 64 + vsx] = (bf16_t)(w & 0xffffu); Vt[(vd8 * 8 + 2 * j + 1) * 200 + jb * 64 + vsx] = (bf16_t)(w >> 16); }
        }
    }
    __syncthreads();
#pragma unroll 1
    for (int ti = 0; ti < 2; ++ti) {
        const int task = wid + 8 * ti;
        const int gi = task >> 2, tt = task & 3, hh = kvh * 4 + gi;
        const int t = 16 * tt + fr;
        const float slope = exp2f(-(float)(hh + 1)), sink = p.sinks[hh];
        int tq = t + 128; asm volatile("" : "+v"(tq));
        bf16x8 Qn[2];
#pragma unroll
        for (int kd = 0; kd < 2; ++kd) Qn[kd] = *(const bf16x8*)(qbase + 128 + 32 * kd);
        f32x4 sc[12];
        float mx = sink;
#pragma unroll
        for (int tile = 0; tile < 12; ++tile) {
            if (tile >= 4 * jb0) {
                f32x4 acc = (f32x4){0.f, 0.f, 0.f, 0.f};
#pragma unroll
                for (int kd = 0; kd < 2; ++kd) { const bf16x8 Kf = *(const LAS bf16x8*)(Ks + (16 * tile + fr) * 72 + 32 * kd + 8 * fq); acc = mfma16(Kf, Qf[kd], acc); }
#pragma unroll
                for (int r = 0; r < 4; ++r) {
                    const int s = 16 * tile + 4 * fq + r;
                    const float d = fabsf((float)(tq - s));
                    acc[r] = acc[r] * 0.125f - slope * d;
                    mx = fmaxf(mx, acc[r]);
                }
                sc[tile] = acc;
            } else sc[tile] = (f32x4){-INFINITY, -INFINITY, -INFINITY, -INFINITY};
        }
        mx = fmaxf(mx, __shfl_xor(mx, 16)); mx = fmaxf(mx, __shfl_xor(mx, 32));
        float l = 0.f;
#pragma unroll
        for (int tile = 0; tile < 12; ++tile)
#pragma unroll
            for (int r = 0; r < 4; ++r) { const float e = __expf(sc[tile][r] - mx); sc[tile][r] = e; l += e; }
        l += __shfl_xor(l, 16); l += __shfl_xor(l, 32);
        l += __expf(sink - mx);
        const float rl = 1.0f / l;
        f32x4 o[4];
#pragma unroll
        for (int dt = 0; dt < 4; ++dt) o[dt] = (f32x4){0.f, 0.f, 0.f, 0.f};
#pragma unroll
        for (int k6 = 0; k6 < 6; ++k6) {
            if (k6 >= 2 * jb0) {
                union { u32x4 u; bf16x8 b; } pf;
                pf.u = (u32x4){cvt_pk_bf16(sc[2 * k6][0], sc[2 * k6][1]), cvt_pk_bf16(sc[2 * k6][2], sc[2 * k6][3]), cvt_pk_bf16(sc[2 * k6 + 1][0], sc[2 * k6 + 1][1]), cvt_pk_bf16(sc[2 * k6 + 1][2], sc[2 * k6 + 1][3])};
#pragma unroll
                for (int dt = 0; dt < 4; ++dt) {
                    union { u32x4 u; bf16x8 b; } vf;
                    const u32x2 lo = *(const LAS u32x2*)(Vt + (16 * dt + fr) * 200 + 32 * k6 + 4 * fq), hi = *(const LAS u32x2*)(Vt + (16 * dt + fr) * 200 + 32 * k6 + 16 + 4 * fq);
                    vf.u = (u32x4){lo.x, lo.y, hi.x, hi.y};
                    o[dt] = mfma16(vf.b, pf.b, o[dt]);
                }
            }
        }
#pragma unroll
        for (int dt = 0; dt < 4; ++dt) {
            u32x2 w; w.x = cvt_pk_bf16(o[dt][0] * rl, o[dt][1] * rl); w.y = cvt_pk_bf16(o[dt][2] * rl, o[dt][3] * rl);
            *(u32x2*)(ymix + (row0 + t) * DM + 512 + hh * 64 + 16 * dt + 4 * fq) = w;
        }
        Qf[0] = Qn[0]; Qf[1] = Qn[1];
    }
}

__device__ __forceinline__ void mixer_phase_a(const Params& p, LAS unsigned char* lds) {
    for (int u = blockIdx.x; u < 256; u += gridDim.x) {
        const int bh = u >> 2, seg = u & 3, b = bh >> 2, h = bh & 3;
        hgrn_unit(p, b * 4096 + seg * 1024, 16, h, (const float*)(p.ws + W_ZERO), (float*)(p.ws + W_SSEG) + (size_t)u * 16384, seg ? 1 : 0,
                  (float*)(p.ws + W_DSEG) + (size_t)u * 128, lds);
    }
}
__device__ __forceinline__ void mixer_small_item(const Params& p, int it, LAS unsigned char* lds) {
    if (it < 2112) attn_unit(p, it, lds);
    else { const int su = it - 2112, sb = su >> 2, h = su & 3; hgrn_unit(p, TP + sb * 64, 1, h, p.state + (size_t)su * 16384, p.out + O_STS + (size_t)su * 16384, 0, nullptr, lds); }
}
__device__ __forceinline__ void mixer_phase_b(const Params& p, LAS unsigned char* lds) {
    if (gridDim.x == 256) {
        const int b = blockIdx.x;
        if (b < 192) hgrn_fix_unit(p, b / 3, 1 + b % 3, lds);
        const int i0 = b < 64 ? 8 * b : (b < 192 ? 512 + 7 * (b - 64) : 1408 + 13 * (b - 192)), n = b < 64 ? 8 : (b < 192 ? 7 : 13);
        for (int i = 0; i < n; ++i) mixer_small_item(p, i0 + i, lds);
    } else {
        for (int it = blockIdx.x; it < 192 + 2240; it += gridDim.x) {
            if (it < 192) hgrn_fix_unit(p, it / 3, 1 + it % 3, lds);
            else mixer_small_item(p, it - 192, lds);
        }
    }
}

#define XB_TMO      128
#define XB_XCNT(j)  (256  + 64 * (j))
#define XB_XSUB(j)  (1280 + 64 * (j))
#define XB_XGEN(j)  (2304 + 64 * (j))
#define XB_TOP      3328
#define XB_TOPGEN   3392
#define XCD_BAR_WORDS 3456
#define XB_SPIN_CAP (1u << 18)

__device__ __forceinline__ unsigned xb_ld(unsigned* p)              { return __hip_atomic_load(p, __ATOMIC_RELAXED, __HIP_MEMORY_SCOPE_AGENT); }
__device__ __forceinline__ unsigned xb_add(unsigned* p, unsigned v) { return __hip_atomic_fetch_add(p, v, __ATOMIC_RELAXED, __HIP_MEMORY_SCOPE_AGENT); }
__device__ __forceinline__ unsigned xb_xcc_id() { return (unsigned)__builtin_amdgcn_s_getreg((3 << 11) | 20) & 0xFu; }
#define XB_SPIN(cond, bar) do { unsigned _sp = 0; while (cond) { __builtin_amdgcn_s_sleep(1); \
    if ((++_sp & 255u) == 0u) { if (xb_ld(&(bar)[XB_TMO])) break; if (_sp > XB_SPIN_CAP) { atomicAdd(&(bar)[XB_TMO], 1u); break; } } } } while (0)

struct XcdBarrier {
    unsigned* bar; unsigned x;
    volatile LAS unsigned* st;
};

__device__ __forceinline__ XcdBarrier xcd_barrier_post(unsigned* bar, volatile LAS unsigned* st) {
    XcdBarrier b; b.bar = bar; b.x = xb_xcc_id(); b.st = st;
    if (threadIdx.x == 0) (void)xb_add(&bar[XB_XCNT(b.x)], 1u);
    return b;
}
__device__ __forceinline__ void xcd_barrier_complete(unsigned* bar, unsigned x, unsigned& nloc, unsigned& nx) {
    const unsigned G = gridDim.x * gridDim.y * gridDim.z;
    unsigned sum, cnt, mine, sp = 0u;
    for (;;) {
        sum = 0u; cnt = 0u; mine = 0u;
#pragma unroll
        for (unsigned j = 0; j < 16; ++j) { const unsigned c = xb_ld(&bar[XB_XCNT(j)]); sum += c; cnt += (c > 0u) ? 1u : 0u; mine = (j == x) ? c : mine; }
        if (sum == G) break;
        __builtin_amdgcn_s_sleep(1);
        if ((++sp & 255u) == 0u) { if (xb_ld(&bar[XB_TMO])) break; if (sp > XB_SPIN_CAP) { atomicAdd(&bar[XB_TMO], 1u); break; } }
    }
    nloc = mine > 0u ? mine : 1u; nx = cnt > 0u ? cnt : 1u;
}

__device__ __forceinline__ void xcd_barrier(const XcdBarrier& b) {
    asm volatile("s_waitcnt vmcnt(0)" ::: "memory");
    __syncthreads();
    if (threadIdx.x == 0) {
        unsigned* bar = b.bar;
        __builtin_amdgcn_s_waitcnt(0);
        unsigned nloc = b.st[0], nx = b.st[1];
        if (nloc == 0u) { xcd_barrier_complete(bar, b.x, nloc, nx); b.st[0] = nloc; b.st[1] = nx; }
        const unsigned old = xb_add(&bar[XB_XSUB(b.x)], 1u);
        const unsigned gen = old / nloc;
        if (old + 1u == (gen + 1u) * nloc) {
            __builtin_amdgcn_fence(__ATOMIC_RELEASE, "agent");
            asm volatile("s_waitcnt vmcnt(0)" ::: "memory");
            const unsigned og = xb_add(&bar[XB_TOP], 1u);
            const unsigned tg = og / nx;
            if (og + 1u == (tg + 1u) * nx) xb_add(&bar[XB_TOPGEN], 1u);
            else XB_SPIN(xb_ld(&bar[XB_TOPGEN]) == tg, bar);
            __builtin_amdgcn_fence(__ATOMIC_ACQUIRE, "agent");
            xb_add(&bar[XB_XGEN(b.x)], 1u);
            asm volatile("s_waitcnt vmcnt(0)" ::: "memory");
        } else {
            XB_SPIN(xb_ld(&bar[XB_XGEN(b.x)]) == gen, bar);
            __builtin_amdgcn_fence(__ATOMIC_ACQUIRE, "agent");
            asm volatile("s_waitcnt vmcnt(0)" ::: "memory");
        }
    }
    __syncthreads();
}


__global__ void __launch_bounds__(512, 2) mk_fwd(Params p) {
    extern __shared__ __attribute__((aligned(16))) unsigned char lds_raw[];
    LAS unsigned char* lds = (LAS unsigned char*)lds_raw;
    cg::grid_group grid = cg::this_grid();
    volatile LAS unsigned* xst = (volatile LAS unsigned*)(lds + 131072 + 256);
    if (threadIdx.x == 0) { xst[0] = 0u; xst[1] = 0u; }
    __syncthreads();
    const XcdBarrier xb = xcd_barrier_post((unsigned*)(p.ws + W_BAR), xst);
    float* mod = (float*)(p.ws + W_MOD);
    bf16_t* hbuf = (bf16_t*)(p.ws + W_H);
    bf16_t* hidden = (bf16_t*)(p.ws + W_BIG);
    float* xres = p.out + O_Y;
    bf16_t* xr = (bf16_t*)(p.out + O_Y);
    pg8::StaticOrder so;
#ifndef PH_MASK
#define PH_MASK 0x3FFF
#endif
#define PHASE_BEGIN(i) if (((PH_MASK >> (i)) & 1) && p.ph_lo <= (i) && (i) < p.ph_hi) { if ((i) > p.ph_lo) xcd_barrier(xb);
#define PHASE_END }
    bf16_t* hb2 = (bf16_t*)(p.ws + W_HB2);
    float* ssq2 = (float*)(p.ws + W_SSQ); float* ssq3 = ssq2 + T;
    float* shwi = (float*)(p.ws + W_SHWI); float* shwu = (float*)(p.ws + W_SHWU);
    bf16_t* ash = (bf16_t*)(p.ws + W_ASH);
    if (p.ph_hi > NPHASE) grid.sync();
    PHASE_BEGIN(0) phase0(p, lds); PHASE_END
    PHASE_BEGIN(1) {
        norm_mod_phase(p.x_p, p.x_s, p.g_ffn1, mod, 0, 1, hbuf);
        for (int i = blockIdx.x * 512 + threadIdx.x; i < 2 * 256 * DM; i += gridDim.x * 512) {
            const int w = i / (256 * DM), r = (i / DM) & 255, k = i & (DM - 1);
            ash[i] = r < NB ? (bf16_t)(cvt_pk_bf16(mod[(size_t)r * NMOD + (w ? 6 : 3) * DM + k], 0.f) & 0xffffu) : (bf16_t)0;
        }
    } PHASE_END
    PHASE_BEGIN(2) {
        { so.init(T, 2 * DFF, gridDim.x, blockIdx.x); pg8::Gemm g{hbuf, (const bf16_t*)(p.ws + W_UP1), T, 2 * DFF, DM}; EpiSwiglu e{hidden, nullptr, nullptr}; pg8::gemm_phase(lds, g, so, e); }
        { so.init(256, DIN, gridDim.x, (blockIdx.x + 80) & 255); pg8::Gemm g{ash, (const bf16_t*)(p.ws + W_IN), 256, DIN, DM}; EpiPlainF32 e{shwi, DIN}; pg8::gemm_phase(lds, g, so, e); }
        { so.init(256, 2 * DFF, gridDim.x, (blockIdx.x + 69) & 255); pg8::Gemm g{ash + 256 * DM, (const bf16_t*)(p.ws + W_UP2), 256, 2 * DFF, DM}; EpiPlainF32 e{shwu, 2 * DFF}; pg8::gemm_phase(lds, g, so, e); }
    } PHASE_END
    PHASE_BEGIN(3) { so.init(TP, DM, gridDim.x, blockIdx.x); pg8::Gemm g{hidden, (const bf16_t*)(p.ws + W_DN1), T, DM, DFF}; EpiResid<1, false> e{p.x_p, p.x_s, nullptr, xr, mod + 2 * DM, hbuf, p.g_mix, mod + 4 * DM, ssq2, 0.5f, 0}; pg8::gemm_phase(lds, g, so, e); } PHASE_END
    PHASE_BEGIN(4) {
        if (blockIdx.x < 32) { so.init(TS, DM, 32, blockIdx.x, 256); pg8::Gemm g{hidden, (const bf16_t*)(p.ws + W_DN1), T, DM, DFF}; EpiResid<1, false> e{p.x_p, p.x_s, nullptr, xr, mod + 2 * DM, hbuf, p.g_mix, mod + 4 * DM, ssq2, 0.5f, 0}; pg8::gemm_phase(lds, g, so, e); }
        else { so.init(TP, DIN, gridDim.x - 32, blockIdx.x - 32); so.range(0, 2 * ((int)gridDim.x - 32)); pg8::Gemm g{hbuf, (const bf16_t*)(p.ws + W_IN), T, DIN, DM}; EpiInproj e{p.ws + W_BIG, p.lb_logits, p.out, ssq2, shwi}; pg8::gemm_phase(lds, g, so, e); }
    } PHASE_END
    PHASE_BEGIN(5) {
        { so.init(TP, DIN, gridDim.x, blockIdx.x); so.range(2 * ((int)gridDim.x - 32), so.nwg); pg8::Gemm g{hbuf, (const bf16_t*)(p.ws + W_IN), T, DIN, DM}; EpiInproj e{p.ws + W_BIG, p.lb_logits, p.out, ssq2, shwi}; pg8::gemm_phase(lds, g, so, e); }
        { so.init(TS, DIN, gridDim.x, (blockIdx.x + 192) & 255, 256); pg8::Gemm g{hbuf, (const bf16_t*)(p.ws + W_IN), T, DIN, DM}; EpiInproj e{p.ws + W_BIG, p.lb_logits, p.out, ssq2, shwi}; pg8::gemm_phase(lds, g, so, e); }
    } PHASE_END
    PHASE_BEGIN(6) mixer_phase_a(p, lds); PHASE_END
    PHASE_BEGIN(7) mixer_phase_b(p, lds); PHASE_END
    PHASE_BEGIN(8) { so.init(TP, DM, gridDim.x, blockIdx.x); pg8::Gemm g{hbuf, (const bf16_t*)(p.ws + W_OUT), T, DM, DM}; EpiResid<1, true> e{nullptr, nullptr, xr, xr, mod + 5 * DM, hb2, p.g_ffn2, mod + 7 * DM, ssq3, 1.0f, 0}; pg8::gemm_phase(lds, g, so, e); } PHASE_END
    PHASE_BEGIN(9) {
        if (blockIdx.x < 32) { so.init(TS, DM, 32, blockIdx.x, 256); pg8::Gemm g{hbuf, (const bf16_t*)(p.ws + W_OUT), T, DM, DM}; EpiResid<1, true> e{nullptr, nullptr, xr, xr, mod + 5 * DM, hb2, p.g_ffn2, mod + 7 * DM, ssq3, 1.0f, 0}; pg8::gemm_phase(lds, g, so, e); }
        else { so.init(TP, 2 * DFF, gridDim.x - 32, blockIdx.x - 32); so.range(0, 2 * ((int)gridDim.x - 32)); pg8::Gemm g{hb2, (const bf16_t*)(p.ws + W_UP2), T, 2 * DFF, DM}; EpiSwiglu e{hidden, ssq3, shwu}; pg8::gemm_phase(lds, g, so, e); }
    } PHASE_END
    PHASE_BEGIN(10) {
        { so.init(TP, 2 * DFF, gridDim.x, blockIdx.x); so.range(2 * ((int)gridDim.x - 32), so.nwg); pg8::Gemm g{hb2, (const bf16_t*)(p.ws + W_UP2), T, 2 * DFF, DM}; EpiSwiglu e{hidden, ssq3, shwu}; pg8::gemm_phase(lds, g, so, e); }
        { so.init(TS, 2 * DFF, gridDim.x, (blockIdx.x + 192) & 255, 256); pg8::Gemm g{hb2, (const bf16_t*)(p.ws + W_UP2), T, 2 * DFF, DM}; EpiSwiglu e{hidden, ssq3, shwu}; pg8::gemm_phase(lds, g, so, e); }
    } PHASE_END
    PHASE_BEGIN(11) { so.init(TP, DM, gridDim.x, blockIdx.x); pg8::Gemm g{hidden, (const bf16_t*)(p.ws + W_DN2), TP, DM, DFF}; EpiResid<2, true> e{nullptr, nullptr, xr, nullptr, mod + 8 * DM, hbuf, p.g_final, nullptr, ssq2 + 2 * T, 0.5f, 0}; pg8::gemm_phase(lds, g, so, e); } PHASE_END
    PHASE_BEGIN(12) {
        so.init(TS, DM, gridDim.x, blockIdx.x, 256);
        const int nsamp = so.nwg < (int)gridDim.x ? so.nwg : (int)gridDim.x;
        if ((int)blockIdx.x < nsamp || nsamp == (int)gridDim.x) { pg8::Gemm g{hidden, (const bf16_t*)(p.ws + W_DN2), T, DM, DFF}; EpiResid<2, true> e{nullptr, nullptr, xr, nullptr, mod + 8 * DM, hbuf, p.g_final, nullptr, ssq2 + 2 * T, 0.5f, 0}; pg8::gemm_phase(lds, g, so, e); }
        if (nsamp == (int)gridDim.x) final_norm_phase<0>(xres, hbuf, ssq2 + 2 * T, blockIdx.x, gridDim.x);
        else if ((int)blockIdx.x >= nsamp) final_norm_phase<0>(xres, hbuf, ssq2 + 2 * T, blockIdx.x - nsamp, gridDim.x - nsamp);
    } PHASE_END
    PHASE_BEGIN(13) final_norm_phase<1>(xres, hbuf, ssq2 + 2 * T, blockIdx.x, gridDim.x); PHASE_END
}

extern "C" void kernel_launch(void* const* d_in, const int* in_sizes, int n_in, void* d_out, int out_size, void* d_ws, size_t ws_size, hipStream_t stream) {
    static int grid_blocks = 0;
    if (!grid_blocks) {
        int dev = 0, cus = 0, per_cu = 0;
        hipGetDevice(&dev);
        hipDeviceGetAttribute(&cus, hipDeviceAttributeMultiprocessorCount, dev);
        hipFuncSetAttribute((const void*)mk_fwd, hipFuncAttributeMaxDynamicSharedMemorySize, LDS_BYTES);
        hipOccupancyMaxActiveBlocksPerMultiprocessor(&per_cu, (const void*)mk_fwd, 512, LDS_BYTES);
        if (per_cu < 1) per_cu = 1;
        grid_blocks = cus * per_cu;
        if (grid_blocks > 256) grid_blocks = 256;
        if (ws_size < WS_NEED) fprintf(stderr, "kernel_launch: workspace too small: %zu < %zu\n", ws_size, (size_t)WS_NEED);
    }
    Params p{};
    const float** pp = (const float**)&p;
    for (int i = 0; i < 22; ++i) pp[i] = (const float*)d_in[i];
    p.out = (float*)d_out; p.ws = (unsigned char*)d_ws;
    hipMemsetAsync((unsigned char*)d_ws + W_BAR, 0, 16384, stream);
#if MK_LAUNCHES == 1
    p.ph_lo = 0; p.ph_hi = NPHASE;
    void* args[] = {&p};
    hipError_t e = hipLaunchCooperativeKernel((const void*)mk_fwd, dim3(grid_blocks), dim3(512), args, LDS_BYTES, stream);
    if (e != hipSuccess) fprintf(stderr, "cooperative launch failed: %s (grid %d)\n", hipGetErrorString(e), grid_blocks);
#else
    for (int i = 0; i < NPHASE; ++i) { p.ph_lo = i; p.ph_hi = i + 1; hipLaunchKernelGGL(mk_fwd, dim3(grid_blocks), dim3(512), LDS_BYTES, stream, p); }
#endif
}
```
